# Optimizing an MI355X kernel written in HIP

```python
import jax, jax.numpy as jnp
from jax import lax
import numpy as np

D_MODEL = 2048
BATCH = 2
SEQ = 8192
DEPTH = 4

GRID_W = 64
GLA_HEADS = 4
GLA_DK = D_MODEL // 4
GLA_DV = D_MODEL // 2
GLA_HK = GLA_DK // GLA_HEADS
GLA_HV = GLA_DV // GLA_HEADS
GLA_GATE_RANK = 16
GLA_TAU = 16.0
GLA_CHUNK = 64
NA_HD = 64
NA_WIDTH = D_MODEL // 4
NA_HEADS = NA_WIDTH // NA_HD
NA_ROWS = 8
NA_COLS = 16
NA_QB_W = 16
NA_KB_W = NA_QB_W + NA_COLS
MEM_TOKENS = 256
MEM_HEADS = 4
MEM_WIDTH = D_MODEL // 4
MEM_HD = MEM_WIDTH // MEM_HEADS
MIX_WIDTH = GLA_DV + NA_WIDTH + MEM_WIDTH
IN_SPLITS = (GLA_DK, GLA_DK, GLA_DV, GLA_DV, GLA_GATE_RANK, GLA_GATE_RANK,
             NA_WIDTH, NA_WIDTH, NA_WIDTH, MEM_WIDTH)
IN_COLS = sum(IN_SPLITS)
D_FF = ((8 * D_MODEL // 3 + 255) // 256) * 256
RMS_EPS = 1e-6

kernel_name = "hybrid_gla_natten_mem_encoder"


def rms_norm(x, g):
    xf = x.astype(jnp.float32)
    y = xf * lax.rsqrt(jnp.mean(xf * xf, axis=-1, keepdims=True) + RMS_EPS)
    return (y * g.astype(jnp.float32)).astype(x.dtype)


def head_rms_norm(t, g, n_heads):
    B, S, W = t.shape
    y = rms_norm(t.reshape(B, S, n_heads, W // n_heads), g.reshape(n_heads, W // n_heads))
    return y.reshape(B, S, W)


def split_heads(t, n_heads):
    B, S, W = t.shape
    return t.reshape(B, S, n_heads, W // n_heads).transpose(0, 2, 1, 3)


def merge_heads(t):
    B, H, S, d = t.shape
    return t.transpose(0, 2, 1, 3).reshape(B, S, H * d)


def gla_chunked(q, k, v, log_a, strict):
    B, H, S, dk = q.shape
    dv = v.shape[-1]
    C = GLA_CHUNK
    N = S // C
    qc = q.astype(jnp.float32).reshape(B, H, N, C, dk)
    kc = k.astype(jnp.float32).reshape(B, H, N, C, dk)
    vc = v.astype(jnp.float32).reshape(B, H, N, C, dv)
    cum = jnp.cumsum(log_a.astype(jnp.float32).reshape(B, H, N, C, dk), axis=3)
    last = cum[:, :, :, -1:, :]
    q_e = qc * jnp.exp(cum)
    k_e = kc * jnp.exp(-cum)
    k_end = kc * jnp.exp(last - cum)
    scores = jnp.einsum('bhnqd,bhnkd->bhnqk', q_e, k_e)
    mask = np.tril(np.ones((C, C), dtype=bool), k=-1 if strict else 0)
    scores = jnp.where(mask, scores, 0.0)
    o_intra = jnp.einsum('bhnqk,bhnke->bhnqe', scores, vc)
    kv = jnp.einsum('bhnkd,bhnke->nbhde', k_end, vc)
    decay = jnp.exp(last[:, :, :, 0, :]).transpose(2, 0, 1, 3)

    def step(state, inp):
        dec, kv_n = inp
        return dec[..., None] * state + kv_n, state

    _, s_prev = lax.scan(step, jnp.zeros((B, H, dk, dv), jnp.float32), (decay, kv))
    o_inter = jnp.einsum('bhnqd,nbhde->bhnqe', q_e, s_prev)
    return (o_intra + o_inter).reshape(B, H, S, dv)


def gla_group(q_in, k_in, v_in, r_in, gf_in, gb_in, wg2_f, bg_f, wg2_b, bg_b, out_norm):
    q = split_heads(q_in, GLA_HEADS) * (GLA_HK ** -0.5)
    k = split_heads(k_in, GLA_HEADS)
    v = split_heads(v_in, GLA_HEADS)
    z_f = gf_in.astype(jnp.float32) @ wg2_f.astype(jnp.float32) + bg_f.astype(jnp.float32)
    z_b = gb_in.astype(jnp.float32) @ wg2_b.astype(jnp.float32) + bg_b.astype(jnp.float32)
    la_f = split_heads(jax.nn.log_sigmoid(z_f) / GLA_TAU, GLA_HEADS)
    la_b = split_heads(jax.nn.log_sigmoid(z_b) / GLA_TAU, GLA_HEADS)
    o_f = gla_chunked(q, k, v, la_f, strict=False)
    flip = lambda t: jnp.flip(t, axis=2)
    o_b = flip(gla_chunked(flip(q), flip(k), flip(v), flip(la_b), strict=True))
    o = merge_heads(o_f + o_b).astype(q_in.dtype)
    o = head_rms_norm(o, out_norm, GLA_HEADS)
    return o * jax.nn.silu(r_in)


def natten2d(q, k, v, rpb):
    B, H, S, dh = q.shape
    rows = S // GRID_W
    kr = min(NA_ROWS, rows)
    nj = GRID_W // NA_QB_W
    r = np.arange(rows)
    rs = np.clip(r - kr // 2, 0, rows - kr)
    c0 = np.arange(nj) * NA_QB_W
    kc0 = np.clip(c0 - NA_COLS // 2, 0, GRID_W - NA_KB_W)
    key_rows = rs[:, None] + np.arange(kr)[None, :]
    key_cols = kc0[:, None] + np.arange(NA_KB_W)[None, :]
    nk = kr * NA_KB_W
    idx = (key_rows[:, None, :, None] * GRID_W + key_cols[None, :, None, :]).reshape(-1)
    k_blk = jnp.take(k, idx, axis=2).reshape(B, H, rows, nj, nk, dh)
    v_blk = jnp.take(v, idx, axis=2).reshape(B, H, rows, nj, nk, dh)
    q_blk = q.reshape(B, H, rows, nj, NA_QB_W, dh)
    qcol = c0[:, None] + np.arange(NA_QB_W)[None, :]
    cs = np.clip(qcol - NA_COLS // 2, 0, GRID_W - NA_COLS)
    in_win = (key_cols[:, None, :] >= cs[:, :, None]) & (key_cols[:, None, :] < cs[:, :, None] + NA_COLS)
    mask = np.broadcast_to(in_win[:, :, None, :], (nj, NA_QB_W, kr, NA_KB_W)).reshape(nj, NA_QB_W, nk)
    dr = key_rows - r[:, None] + (NA_ROWS - 1)
    dc = np.clip(key_cols[:, None, :] - qcol[:, :, None], -(NA_COLS - 1), NA_COLS - 1) + (NA_COLS - 1)
    bias = rpb[:, dr[:, None, None, :, None], dc[None, :, :, None, :]].reshape(H, rows, nj, NA_QB_W, nk)
    s = jnp.einsum('bhrjqd,bhrjkd->bhrjqk', q_blk, k_blk).astype(jnp.float32) * (dh ** -0.5)
    s = s + bias[None].astype(jnp.float32)
    s = jnp.where(mask, s, -jnp.inf)
    p = jax.nn.softmax(s, axis=-1).astype(v.dtype)
    o = jnp.einsum('bhrjqk,bhrjkd->bhrjqd', p, v_blk)
    return o.reshape(B, H, S, dh)


def natten_group(q_in, k_in, v_in, q_norm, k_norm, rpb, out_norm):
    q = rms_norm(split_heads(q_in, NA_HEADS), q_norm)
    k = rms_norm(split_heads(k_in, NA_HEADS), k_norm)
    v = split_heads(v_in, NA_HEADS)
    o = merge_heads(natten2d(q, k, v, rpb))
    return head_rms_norm(o, out_norm, NA_HEADS)


def memory_group(q_in, mem, mem_norm, mem_wkv, q_norm, k_norm, out_norm):
    q = rms_norm(split_heads(q_in, MEM_HEADS), q_norm)
    kv = rms_norm(mem, mem_norm) @ mem_wkv
    k_m, v_m = jnp.split(kv, 2, axis=-1)
    k_m = rms_norm(split_heads(k_m, MEM_HEADS), k_norm)
    v_m = split_heads(v_m, MEM_HEADS)
    s = jnp.einsum('bhqd,bhkd->bhqk', q, k_m).astype(jnp.float32) * (MEM_HD ** -0.5)
    p = jax.nn.softmax(s, axis=-1).astype(v_m.dtype)
    o = merge_heads(jnp.einsum('bhqk,bhkd->bhqd', p, v_m))
    return head_rms_norm(o, out_norm, MEM_HEADS)


def setup_inputs(seed: int = 0) -> dict:
    key = jax.random.key(seed)
    ks = jax.random.split(key, 22)
    f32 = jnp.float32

    def nrm(k, shape, scale):
        return jax.random.normal(k, shape, f32) * scale

    def gain(k, shape):
        return 1.0 + 0.05 * jax.random.normal(k, shape, f32)

    out_scale = (2 * DEPTH) ** -0.5
    return {
        "x": nrm(ks[0], (BATCH, SEQ, D_MODEL), 1.0),
        "mem": nrm(ks[1], (BATCH, MEM_TOKENS, D_MODEL), 1.0),
        "attn_norm": gain(ks[2], (DEPTH, D_MODEL)),
        "w_in": nrm(ks[3], (DEPTH, D_MODEL, IN_COLS), D_MODEL ** -0.5),
        "gla_wg2_f": nrm(ks[4], (DEPTH, GLA_GATE_RANK, GLA_DK), GLA_GATE_RANK ** -0.5),
        "gla_bg_f": nrm(ks[5], (DEPTH, GLA_DK), 0.1),
        "gla_wg2_b": nrm(ks[6], (DEPTH, GLA_GATE_RANK, GLA_DK), GLA_GATE_RANK ** -0.5),
        "gla_bg_b": nrm(ks[7], (DEPTH, GLA_DK), 0.1),
        "gla_out_norm": gain(ks[8], (DEPTH, GLA_DV)),
        "na_q_norm": gain(ks[9], (DEPTH, NA_HD)),
        "na_k_norm": gain(ks[10], (DEPTH, NA_HD)),
        "na_rpb": nrm(ks[11], (DEPTH, NA_HEADS, 2 * NA_ROWS - 1, 2 * NA_COLS - 1), 0.1),
        "na_out_norm": gain(ks[12], (DEPTH, NA_WIDTH)),
        "mem_norm": gain(ks[13], (DEPTH, D_MODEL)),
        "mem_wkv": nrm(ks[14], (DEPTH, D_MODEL, 2 * MEM_WIDTH), D_MODEL ** -0.5),
        "mem_q_norm": gain(ks[15], (DEPTH, MEM_HD)),
        "mem_k_norm": gain(ks[16], (DEPTH, MEM_HD)),
        "mem_out_norm": gain(ks[17], (DEPTH, MEM_WIDTH)),
        "w_out": nrm(ks[18], (DEPTH, MIX_WIDTH, D_MODEL), MIX_WIDTH ** -0.5 * out_scale),
        "ffn_norm": gain(ks[19], (DEPTH, D_MODEL)),
        "ffn_w13": nrm(ks[20], (DEPTH, D_MODEL, 2 * D_FF), D_MODEL ** -0.5),
        "ffn_w2": nrm(ks[21], (DEPTH, D_FF, D_MODEL), D_FF ** -0.5 * out_scale),
    }


def reference(x, mem, attn_norm, w_in, gla_wg2_f, gla_bg_f, gla_wg2_b, gla_bg_b, gla_out_norm,
              na_q_norm, na_k_norm, na_rpb, na_out_norm, mem_norm, mem_wkv, mem_q_norm, mem_k_norm,
              mem_out_norm, w_out, ffn_norm, ffn_w13, ffn_w2):
    split_points = np.cumsum(IN_SPLITS)[:-1].tolist()
    for l in range(DEPTH):
        xn = rms_norm(x, attn_norm[l])
        proj = xn @ w_in[l]
        (g_q, g_k, g_v, g_r, g_f, g_b, n_q, n_k, n_v, m_q) = jnp.split(proj, split_points, axis=-1)
        y_gla = gla_group(g_q, g_k, g_v, g_r, g_f, g_b, gla_wg2_f[l], gla_bg_f[l],
                          gla_wg2_b[l], gla_bg_b[l], gla_out_norm[l])
        y_na = natten_group(n_q, n_k, n_v, na_q_norm[l], na_k_norm[l], na_rpb[l], na_out_norm[l])
        y_mem = memory_group(m_q, mem, mem_norm[l], mem_wkv[l], mem_q_norm[l], mem_k_norm[l],
                             mem_out_norm[l])
        x = x + jnp.concatenate([y_gla, y_na, y_mem], axis=-1) @ w_out[l]
        h = rms_norm(x, ffn_norm[l])
        gate, up = jnp.split(h @ ffn_w13[l], 2, axis=-1)
        x = x + (jax.nn.silu(gate) * up) @ ffn_w2[l]
    return x
```

```cpp
#include <hip/hip_runtime.h>
#include <hip/hip_cooperative_groups.h>
#include <cstdio>
#include <cstdint>
namespace cg = cooperative_groups;
__device__ __forceinline__ int tidx() { int t = threadIdx.x; asm volatile("" : "+v"(t)); return t; }
namespace pg8 {
#define PG8_LAS __attribute__((address_space(3)))
typedef unsigned short bf16_t;
typedef short bf16x8 __attribute__((ext_vector_type(8)));
typedef float f32x4 __attribute__((ext_vector_type(4)));
typedef unsigned u32x4 __attribute__((ext_vector_type(4)));
constexpr int BM = 256, BK = 64, HALF = 128, HTB = HALF * BK * 2  , STAGE_BYTES = 8 * HTB, NXCD = 8, WGM = 8;

__host__ __device__ __forceinline__ int lds_byte(int r, int c) { const int st = (r >> 4) * 2 + (c >> 5), rr = r & 15, cc = c & 31, ob = rr * 64 + cc * 2; return st * 1024 + (ob ^ (((ob >> 9) & 1) << 5)); }
__host__ __device__ __forceinline__ void stage_rc(int b, int& R, int& C) { const int st = b / 1024, sb = b % 1024, swz = sb ^ (((sb >> 9) & 1) << 5); R = (st >> 1) * 16 + swz / 64; C = (st & 1) * 32 + (swz % 64) / 2; }
__host__ __device__ __forceinline__ int perm32(int rho) { const int n = rho >> 4, i = rho & 15; return 8 * (i >> 2) + 4 * n + (i & 3); }

struct Unit { int pm, pn; };
struct Gemm { const bf16_t* A; const bf16_t* Bt; int M, N, K; };

struct StaticOrder {
    int nM, nN, nwg, G, c;
    __host__ __device__ void init(int M, int N, int G_, int c_) { nM = M / BM; nN = N / BM; nwg = nM * nN; G = G_; c = c_; }
    __host__ __device__ bool next(int i, Unit& u) const {
        const long L = (long)i * G + c; if (L >= nwg) return false;
        int wgid = (int)L; { const int q = nwg / NXCD, r = nwg % NXCD, xcd = wgid % NXCD, off = wgid / NXCD; wgid = (xcd < r ? xcd * (q + 1) : r * (q + 1) + (xcd - r) * q) + off; }
        const int nig = WGM * nN, gid = wgid / nig, fm = gid * WGM, gsz = (nM - fm) < WGM ? (nM - fm) : WGM;
        u.pm = fm + ((wgid % nig) % gsz); u.pn = (wgid % nig) / gsz; return true;
    }
    __device__ __forceinline__ void a_ready(const Unit&) const {}
    __device__ __forceinline__ void done(const Unit&) const {}
};

typedef float f32x2_t __attribute__((ext_vector_type(2))); typedef __bf16 bf16x2_t __attribute__((ext_vector_type(2)));
__device__ __forceinline__ unsigned cvt_pk_bf16(float lo, float hi) { f32x2_t v = {lo, hi}; bf16x2_t b = __builtin_convertvector(v, bf16x2_t); return __builtin_bit_cast(unsigned, b); }
template <class Epi, class Sched, bool ALIGN_EPI = false, bool SP2 = false>
__device__ __forceinline__ void gemm_phase(PG8_LAS unsigned char* lds, const Gemm g, const Sched& S, const Epi& E) {
    const int tid = tidx(), wid = __builtin_amdgcn_readfirstlane(tid >> 6), lane = tid & 63, wr = wid >> 2, wc = wid & 3, fr = lane & 15, fq = lane >> 4;
    const int K = g.K, nt = K / BK;
    unsigned voffA[2], voffB[2];
#pragma unroll
    for (int i = 0; i < 2; ++i) { int R, C; stage_rc(tid * 16 + i * 8192, R, C); const int Rb = Epi::PERM ? ((R & ~31) + perm32(R & 31)) : R;
        voffA[i] = (unsigned)(R * K + C) * 2u; voffB[i] = (unsigned)(Rb * K + C) * 2u; }
    const size_t kstep = (size_t)(BK * 2);
    const size_t hstep = (size_t)HALF * K * 2;
    const size_t tstep = 2 * hstep;
    const unsigned ldsw = (unsigned)wid * 1024u;
    const int aoff = lds_byte(wr * 64 + fr, fq * 8), boff = lds_byte(wc * 32 + fr, fq * 8);
#define PG8_SA(b, h) (((b) * 2 + (h)) * HTB)
#define PG8_SB(b, h) ((4 + (b) * 2 + (h)) * HTB)
#define PG8_STAGE(bufoff, gbase, voff) do { _Pragma("unroll") for (int _i = 0; _i < 2; ++_i) \
        __builtin_amdgcn_global_load_lds((const unsigned*)((const char*)(gbase) + (voff)[_i]), (PG8_LAS unsigned*)(lds + (bufoff) + ldsw + _i * 8192), 16, 0, 0); } while (0)
#define PG8_LDA(dst, b, h) do { _Pragma("unroll") for (int m = 0; m < 4; ++m) _Pragma("unroll") for (int k = 0; k < 2; ++k) dst[m][k] = *(const PG8_LAS bf16x8*)(lds + PG8_SA(b, h) + aoff + m * 2048 + k * 1024); } while (0)
#define PG8_LDB(dst, b, h) do { _Pragma("unroll") for (int n = 0; n < 2; ++n) _Pragma("unroll") for (int k = 0; k < 2; ++k) dst[n][k] = *(const PG8_LAS bf16x8*)(lds + PG8_SB(b, h) + boff + n * 2048 + k * 1024); } while (0)
#define PG8_MMA(ai, bj, At, Bt) do { __builtin_amdgcn_s_setprio(1); _Pragma("unroll") for (int m = 0; m < 4; ++m) _Pragma("unroll") for (int n = 0; n < 2; ++n) _Pragma("unroll") for (int k = 0; k < 2; ++k) \
        acc[ai][bj][m][n] = __builtin_amdgcn_mfma_f32_16x16x32_bf16(Bt[n][k], At[m][k], acc[ai][bj][m][n], 0, 0, 0); __builtin_amdgcn_s_setprio(0); } while (0)
#define PG8_WAIT_V(n) asm volatile("s_waitcnt vmcnt(" #n ")" ::: "memory")
#define PG8_WAIT_L(n) asm volatile("s_waitcnt lgkmcnt(" #n ")" ::: "memory")
#define PG8_BAR __builtin_amdgcn_s_barrier()
#define PG8_SCHED __builtin_amdgcn_sched_barrier(0)
    Unit cur, nxt; int ui = 0;
    if (!S.next(0, cur)) return;
    f32x4 acc[2][2][4][2];
#pragma unroll
    for (int a = 0; a < 2; ++a)
#pragma unroll
        for (int b = 0; b < 2; ++b)
#pragma unroll
            for (int m = 0; m < 4; ++m)
#pragma unroll
                for (int n = 0; n < 2; ++n) acc[a][b][m][n] = (f32x4){0.f, 0.f, 0.f, 0.f};
    bf16x8 At[4][2], B0[2][2], B1[2][2];
    const char* cA = (const char*)g.A + (size_t)cur.pm * tstep; const char* cB = (const char*)g.Bt + (size_t)cur.pn * tstep;
    S.a_ready(cur);
    if constexpr (SP2) {
        PG8_STAGE(PG8_SB(0, 0), cB, voffB); PG8_STAGE(PG8_SB(0, 1), cB + hstep, voffB); PG8_STAGE(PG8_SA(0, 0), cA, voffA); PG8_STAGE(PG8_SA(0, 1), cA + hstep, voffA);
        if (wr == 1) PG8_BAR;
        PG8_WAIT_V(2); PG8_BAR;
        PG8_STAGE(PG8_SB(1, 0), cB + kstep, voffB); PG8_STAGE(PG8_SA(1, 0), cA + kstep, voffA); PG8_STAGE(PG8_SB(1, 1), cB + hstep + kstep, voffB);
        PG8_WAIT_V(6); PG8_BAR;
    } else {
        PG8_STAGE(PG8_SB(0, 0), cB, voffB); PG8_STAGE(PG8_SA(0, 0), cA, voffA); PG8_STAGE(PG8_SB(0, 1), cB + hstep, voffB); PG8_STAGE(PG8_SA(0, 1), cA + hstep, voffA);
        if (wr == 1) PG8_BAR;
        PG8_WAIT_V(4); PG8_BAR;
        PG8_STAGE(PG8_SB(1, 0), cB + kstep, voffB); PG8_STAGE(PG8_SA(1, 0), cA + kstep, voffA); PG8_STAGE(PG8_SB(1, 1), cB + hstep + kstep, voffB);
        PG8_WAIT_V(6); PG8_BAR;
    }
    for (;;) {
        const bool has_next = S.next(ui + 1, nxt);
        const char* nA = has_next ? (const char*)g.A + (size_t)nxt.pm * tstep : cA; const char* nB = has_next ? (const char*)g.Bt + (size_t)nxt.pn * tstep : cB;
        for (int t = 0; t < nt; t += 2) {
            const bool last = (t == nt - 2);
            const char* a1 = cA + (size_t)(t + 1) * kstep;
            const char* a2 = last ? nA : cA + (size_t)(t + 2) * kstep; const char* b2 = last ? nB : cB + (size_t)(t + 2) * kstep;
            const char* a3 = a2 + kstep; const char* b3 = b2 + kstep;
            if (last && has_next) S.a_ready(nxt);
            if constexpr (SP2) {
            PG8_LDB(B0, 0, 0); PG8_LDB(B1, 0, 1); PG8_SCHED; PG8_LDA(At, 0, 0); PG8_STAGE(PG8_SA(1, 1), a1 + hstep, voffA);
            PG8_WAIT_V(8); PG8_WAIT_L(0); PG8_BAR; PG8_MMA(0, 0, At, B0); PG8_MMA(0, 1, At, B1); PG8_BAR; PG8_SCHED;
            PG8_LDA(At, 0, 1); PG8_STAGE(PG8_SB(0, 0), b2, voffB); PG8_STAGE(PG8_SB(0, 1), b2 + hstep, voffB); PG8_STAGE(PG8_SA(0, 0), a2, voffA);
            PG8_WAIT_V(8); PG8_WAIT_L(0); PG8_BAR; PG8_MMA(1, 0, At, B0); PG8_MMA(1, 1, At, B1); PG8_BAR; PG8_SCHED;
            PG8_LDB(B0, 1, 0); PG8_LDB(B1, 1, 1); PG8_SCHED; PG8_LDA(At, 1, 0); PG8_STAGE(PG8_SA(0, 1), a2 + hstep, voffA);
            PG8_WAIT_V(8); PG8_WAIT_L(0); PG8_BAR; PG8_MMA(0, 0, At, B0); PG8_MMA(0, 1, At, B1); PG8_BAR; PG8_SCHED;
            PG8_LDA(At, 1, 1); PG8_STAGE(PG8_SB(1, 0), b3, voffB); PG8_STAGE(PG8_SB(1, 1), b3 + hstep, voffB); PG8_STAGE(PG8_SA(1, 0), a3, voffA);
            PG8_WAIT_V(8); PG8_WAIT_L(0); PG8_BAR; PG8_MMA(1, 0, At, B0); PG8_MMA(1, 1, At, B1); PG8_BAR; PG8_SCHED;
            } else {
            PG8_LDB(B0, 0, 0); PG8_SCHED; PG8_LDA(At, 0, 0); PG8_STAGE(PG8_SA(1, 1), a1 + hstep, voffA);
            PG8_WAIT_L(8); PG8_BAR; PG8_WAIT_L(0); PG8_MMA(0, 0, At, B0); PG8_BAR; PG8_SCHED;
            PG8_LDB(B1, 0, 1); PG8_STAGE(PG8_SB(0, 0), b2, voffB);
            PG8_BAR; PG8_WAIT_L(0); PG8_MMA(0, 1, At, B1); PG8_BAR;
            PG8_LDA(At, 0, 1); PG8_STAGE(PG8_SA(0, 0), a2, voffA);
            PG8_BAR; PG8_WAIT_L(0); PG8_MMA(1, 0, At, B0); PG8_BAR; PG8_SCHED;
            PG8_STAGE(PG8_SB(0, 1), b2 + hstep, voffB);
            PG8_WAIT_V(6); PG8_BAR; PG8_MMA(1, 1, At, B1); PG8_BAR;
            PG8_LDB(B0, 1, 0); PG8_SCHED; PG8_LDA(At, 1, 0); PG8_STAGE(PG8_SA(0, 1), a2 + hstep, voffA);
            PG8_WAIT_L(8); PG8_BAR; PG8_WAIT_L(0); PG8_MMA(0, 0, At, B0); PG8_BAR; PG8_SCHED;
            PG8_LDB(B1, 1, 1); PG8_STAGE(PG8_SB(1, 0), b3, voffB);
            PG8_BAR; PG8_WAIT_L(0); PG8_MMA(0, 1, At, B1); PG8_BAR;
            PG8_LDA(At, 1, 1); PG8_STAGE(PG8_SA(1, 0), a3, voffA);
            PG8_BAR; PG8_WAIT_L(0); PG8_MMA(1, 0, At, B0); PG8_BAR; PG8_SCHED;
            PG8_STAGE(PG8_SB(1, 1), b3 + hstep, voffB);
            PG8_WAIT_V(6); PG8_BAR; PG8_MMA(1, 1, At, B1); PG8_BAR;
            }
        }
        if constexpr (ALIGN_EPI) { if (wr == 0) PG8_BAR; }
        if constexpr (!Epi::AFTER_DRAIN) { E(acc, cur, wr, wc, fr, fq); S.done(cur); }
        if (!has_next) break;
#pragma unroll
        for (int a = 0; a < 2; ++a)
#pragma unroll
            for (int b = 0; b < 2; ++b)
#pragma unroll
                for (int m = 0; m < 4; ++m)
#pragma unroll
                    for (int n = 0; n < 2; ++n) acc[a][b][m][n] = (f32x4){0.f, 0.f, 0.f, 0.f};
        cur = nxt; cA = nA; cB = nB; ++ui;
        if constexpr (ALIGN_EPI) { if (wr == 1) PG8_BAR; }
    }
    PG8_WAIT_V(0);
    if constexpr (!ALIGN_EPI) { if (wr == 0) PG8_BAR; }
    PG8_BAR;
    if constexpr (Epi::AFTER_DRAIN) { E.fused(acc, cur, wr, wc, fr, fq, lds, wid, lane); S.done(cur); }
#undef PG8_SA
#undef PG8_SB
#undef PG8_STAGE
#undef PG8_LDA
#undef PG8_LDB
#undef PG8_MMA
#undef PG8_WAIT_V
#undef PG8_WAIT_L
#undef PG8_BAR
#undef PG8_SCHED
}
}

#define LAS __attribute__((address_space(3)))
#define GAS __attribute__((address_space(1)))
#define XB_TMO      128
#define XB_XCNT(j)  (256  + 64 * (j))
#define XB_XSUB(j)  (1280 + 64 * (j))
#define XB_XGEN(j)  (2304 + 64 * (j))
#define XB_TOP      3328
#define XB_TOPGEN   3392
#define XCD_BAR_WORDS 3456
#define XB_SPIN_CAP (1u << 18)

__device__ __forceinline__ unsigned xb_ld(unsigned* p)              { return __hip_atomic_load(p, __ATOMIC_RELAXED, __HIP_MEMORY_SCOPE_AGENT); }
__device__ __forceinline__ unsigned xb_add(unsigned* p, unsigned v) { return __hip_atomic_fetch_add(p, v, __ATOMIC_RELAXED, __HIP_MEMORY_SCOPE_AGENT); }
__device__ __forceinline__ unsigned xb_xcc_id() { return (unsigned)__builtin_amdgcn_s_getreg((3 << 11) | 20) & 0xFu; }
#define XB_SPIN(cond, bar) do { unsigned _sp = 0; while (cond) { __builtin_amdgcn_s_sleep(1); \
    if ((++_sp & 255u) == 0u) { if (xb_ld(&(bar)[XB_TMO])) break; if (_sp > XB_SPIN_CAP) { atomicAdd(&(bar)[XB_TMO], 1u); break; } } } } while (0)

struct XcdBarrier {
    unsigned* bar; unsigned x;
    volatile LAS unsigned* st;
};

__device__ __forceinline__ XcdBarrier xcd_barrier_post(unsigned* bar, volatile LAS unsigned* st) {
    XcdBarrier b; b.bar = bar; b.x = xb_xcc_id(); b.st = st;
    if (threadIdx.x == 0) (void)xb_add(&bar[XB_XCNT(b.x)], 1u);
    return b;
}
__device__ __forceinline__ void xcd_barrier_complete(unsigned* bar, unsigned x, unsigned& nloc, unsigned& nx) {
    const unsigned G = gridDim.x * gridDim.y * gridDim.z;
    unsigned sum, cnt, mine, sp = 0u;
    for (;;) {
        sum = 0u; cnt = 0u; mine = 0u;
#pragma unroll
        for (unsigned j = 0; j < 16; ++j) { const unsigned c = xb_ld(&bar[XB_XCNT(j)]); sum += c; cnt += (c > 0u) ? 1u : 0u; mine = (j == x) ? c : mine; }
        if (sum == G) break;
        __builtin_amdgcn_s_sleep(1);
        if ((++sp & 255u) == 0u) { if (xb_ld(&bar[XB_TMO])) break; if (sp > XB_SPIN_CAP) { atomicAdd(&bar[XB_TMO], 1u); break; } }
    }
    nloc = mine > 0u ? mine : 1u; nx = cnt > 0u ? cnt : 1u;
}

__device__ __forceinline__ void xcd_barrier(const XcdBarrier& b) {
    asm volatile("s_waitcnt vmcnt(0)" ::: "memory");
    __syncthreads();
    if (threadIdx.x == 0) {
        unsigned* bar = b.bar;
        __builtin_amdgcn_s_waitcnt(0);
        unsigned nloc = b.st[0], nx = b.st[1];
        if (nloc == 0u) { xcd_barrier_complete(bar, b.x, nloc, nx); b.st[0] = nloc; b.st[1] = nx; }
        const unsigned old = xb_add(&bar[XB_XSUB(b.x)], 1u);
        const unsigned gen = old / nloc;
        if (old + 1u == (gen + 1u) * nloc) {
            __builtin_amdgcn_fence(__ATOMIC_RELEASE, "agent");
            asm volatile("s_waitcnt vmcnt(0)" ::: "memory");
            const unsigned og = xb_add(&bar[XB_TOP], 1u);
            const unsigned tg = og / nx;
            if (og + 1u == (tg + 1u) * nx) xb_add(&bar[XB_TOPGEN], 1u);
            else XB_SPIN(xb_ld(&bar[XB_TOPGEN]) == tg, bar);
            __builtin_amdgcn_fence(__ATOMIC_ACQUIRE, "agent");
            xb_add(&bar[XB_XGEN(b.x)], 1u);
            asm volatile("s_waitcnt vmcnt(0)" ::: "memory");
        } else {
            XB_SPIN(xb_ld(&bar[XB_XGEN(b.x)]) == gen, bar);
            __builtin_amdgcn_fence(__ATOMIC_ACQUIRE, "agent");
            asm volatile("s_waitcnt vmcnt(0)" ::: "memory");
        }
    }
    __syncthreads();
}

using pg8::bf16_t; using pg8::bf16x8; using pg8::f32x4; using pg8::Unit; using pg8::cvt_pk_bf16;
typedef unsigned u32x2 __attribute__((ext_vector_type(2)));
typedef unsigned u32x4 __attribute__((ext_vector_type(4)));
typedef float f32x2 __attribute__((ext_vector_type(2)));

constexpr int DM = 2048, BATCH = 2, SEQ = 8192, DEPTH = 4, MTOK = BATCH * SEQ;
constexpr int INC = 5152, INP = 5376, DFF = 5632, MEMT = 256;
constexpr int C_GQ = 0, C_GK = 512, C_GV = 1024, C_GR = 2048, C_NQ = 3072, C_NK = 3584, C_NV = 4096, C_MQ = 4608, C_GG = 5120;
constexpr float EPS = 1e-6f;
constexpr int NTHR = 512, NWAVES = 8;

constexpr size_t MiB = 1u << 20;
constexpr size_t WS_WG2T = 65536;
constexpr size_t WS_WIN = 1 * MiB, SZ_WIN = (size_t)INP * DM * 2;
constexpr size_t WS_WOUT = WS_WIN + 4 * SZ_WIN, SZ_WOUT = (size_t)DM * DM * 2;
constexpr size_t WS_W13 = WS_WOUT + 4 * SZ_WOUT, SZ_W13 = (size_t)2 * DFF * DM * 2;
constexpr size_t WS_W2 = WS_W13 + 4 * SZ_W13, SZ_W2 = (size_t)DM * DFF * 2;
constexpr size_t WS_WMEM = WS_W2 + 4 * SZ_W2;
constexpr size_t WS_XB = WS_WMEM + (size_t)4096 * DM * 2;
constexpr size_t WS_SSQ = WS_XB + (size_t)MTOK * DM * 2;
constexpr size_t WS_P = WS_SSQ + (size_t)MTOK * 32 * 4;
constexpr size_t WS_NVT = WS_P + (size_t)MTOK * INP * 2;
constexpr size_t WS_Y = WS_NVT + (size_t)MTOK * 512 * 2;
constexpr size_t WS_ST = WS_Y + (size_t)MTOK * DM * 2;
constexpr size_t WS_DEC = WS_ST + (size_t)2048 * 2 * 32768 * 2;
constexpr size_t WS_MEMN = WS_DEC + (size_t)2048 * 2 * 128 * 4;
constexpr size_t WS_MKV = WS_MEMN + (size_t)512 * DM * 2;
constexpr size_t WS_KM = WS_MKV + (size_t)512 * 4096 * 2;
constexpr size_t WS_VMT = WS_KM + (size_t)32 * 256 * 128 * 2;
constexpr size_t WS_H = WS_VMT + (size_t)32 * 256 * 128 * 2;
constexpr size_t WS_ST2 = WS_H;
constexpr size_t WS_CUMG = WS_ST2 + (size_t)2048 * 2 * 32768 * 2;
constexpr size_t WS_END = WS_CUMG + (size_t)2 * MTOK * 512 * 4;

constexpr int LDS_BYTES = 147456 + 4096;
constexpr int LDS_XB = 147456 + 3584;
#ifndef PHM
#define PHM 255
#endif

__device__ __forceinline__ float bflo(unsigned w) { return __uint_as_float(w << 16); }
__device__ __forceinline__ float bfhi(unsigned w) { return __uint_as_float(w & 0xffff0000u); }
__device__ __forceinline__ float bf2f(unsigned short b) { return __uint_as_float((unsigned)b << 16); }
__device__ __forceinline__ unsigned short f2bf(float f) { return (unsigned short)(cvt_pk_bf16(f, 0.f) & 0xffffu); }
__device__ __forceinline__ float wave_sum(float v) {
#pragma unroll
    for (int o = 1; o < 64; o <<= 1) v += __shfl_xor(v, o);
    return v;
}
__device__ __forceinline__ float fq_sum(float v) { v += __shfl_xor(v, 16); v += __shfl_xor(v, 32); return v; }
__device__ __forceinline__ float fq_max(float v) { v = fmaxf(v, __shfl_xor(v, 16)); v = fmaxf(v, __shfl_xor(v, 32)); return v; }
__device__ __forceinline__ float fr_sum(float v) { v += __shfl_xor(v, 1); v += __shfl_xor(v, 2); v += __shfl_xor(v, 4); v += __shfl_xor(v, 8); return v; }
__device__ __forceinline__ float dot4(f32x4 a) { return (a[0] * a[0] + a[1] * a[1]) + (a[2] * a[2] + a[3] * a[3]); }
__device__ __forceinline__ u32x2 pk4(f32x4 v) { u32x2 w; w.x = cvt_pk_bf16(v[0], v[1]); w.y = cvt_pk_bf16(v[2], v[3]); return w; }
__device__ __forceinline__ bf16x8 pk8(f32x4 a, f32x4 b) { u32x4 w; w.x = cvt_pk_bf16(a[0], a[1]); w.y = cvt_pk_bf16(a[2], a[3]); w.z = cvt_pk_bf16(b[0], b[1]); w.w = cvt_pk_bf16(b[2], b[3]); return __builtin_bit_cast(bf16x8, w); }
__device__ __forceinline__ f32x4 mfma16(bf16x8 a, bf16x8 b, f32x4 c) { return __builtin_amdgcn_mfma_f32_16x16x32_bf16(a, b, c, 0, 0, 0); }

__device__ __forceinline__ void row_rstd(const float* ssq, int rowb, int fq, float (&rs)[2][4]) {
#pragma unroll
    for (int ai = 0; ai < 2; ++ai)
#pragma unroll
        for (int m = 0; m < 4; ++m) {
            const f32x4* sp = (const f32x4*)(ssq + (size_t)(rowb + ai * 128 + m * 16) * 32 + fq * 8);
            const f32x4 a = sp[0], b = sp[1];
            float s = ((a[0] + a[1]) + (a[2] + a[3])) + ((b[0] + b[1]) + (b[2] + b[3]));
            s = fq_sum(s);
            rs[ai][m] = rsqrtf(s * (1.0f / DM) + EPS);
        }
}

struct EpiIn {
    static constexpr bool PERM = false, AFTER_DRAIN = false;
    bf16_t* P; bf16_t* NVT; const float* ssq; const float* gq; const float* gk;
    __device__ __forceinline__ void operator()(const f32x4 (&acc)[2][2][4][2], const Unit& u, int wr, int wc, int fr, int fq) const {
        const int rowb = u.pm * 256 + wr * 64 + fr, pn = u.pn;
        float rs[2][4]; row_rstd(ssq, rowb, fq, rs);
        if (pn >= 12 && pn < 16) {
            const float* g = pn < 14 ? gq : gk; const float sc = pn < 14 ? 0.125f : 1.0f;
            f32x4 gv[2][2];
#pragma unroll
            for (int bj = 0; bj < 2; ++bj)
#pragma unroll
                for (int n = 0; n < 2; ++n) gv[bj][n] = *(const f32x4*)(g + 32 * bj + 16 * n + 4 * fq) * sc;
#pragma unroll
            for (int ai = 0; ai < 2; ++ai)
#pragma unroll
                for (int m = 0; m < 4; ++m) {
                    const float r = rs[ai][m]; float q = 0.f; f32x4 v[2][2];
#pragma unroll
                    for (int bj = 0; bj < 2; ++bj)
#pragma unroll
                        for (int n = 0; n < 2; ++n) { v[bj][n] = acc[ai][bj][m][n] * r; q += dot4(v[bj][n]); }
                    q = fq_sum(q);
                    const float hr = rsqrtf(q * (1.0f / 64.0f) + EPS);
                    bf16_t* rowp = P + (size_t)(rowb + ai * 128 + m * 16) * INP + pn * 256 + 64 * wc + 4 * fq;
#pragma unroll
                    for (int bj = 0; bj < 2; ++bj)
#pragma unroll
                        for (int n = 0; n < 2; ++n) *(u32x2*)(rowp + 32 * bj + 16 * n) = pk4(v[bj][n] * hr * gv[bj][n]);
                    asm volatile("" ::: "memory");
                }
        } else if (pn == 16 || pn == 17) {
#pragma unroll
            for (int ai = 0; ai < 2; ++ai)
#pragma unroll
                for (int m = 0; m < 4; ++m) {
                    const int row = rowb + ai * 128 + m * 16, b = row >> 13, tok = row & 8191; const float r = rs[ai][m];
#pragma unroll
                    for (int bj = 0; bj < 2; ++bj)
#pragma unroll
                        for (int n = 0; n < 2; ++n) {
                            const int c = (pn - 16) * 256 + bj * 128 + wc * 32 + n * 16 + 4 * fq;
                            bf16_t* p = NVT + ((size_t)(b * 512 + c)) * 8192 + tok;
                            const f32x4 v = acc[ai][bj][m][n] * r;
                            p[0] = f2bf(v[0]); p[8192] = f2bf(v[1]); p[2 * 8192] = f2bf(v[2]); p[3 * 8192] = f2bf(v[3]);
                            asm volatile("" ::: "memory");
                        }
                }
        } else {
            const float sc = pn < 2 ? 0.08838834764831845f : 1.0f;
#pragma unroll
            for (int ai = 0; ai < 2; ++ai)
#pragma unroll
                for (int m = 0; m < 4; ++m) {
                    const float r = rs[ai][m] * sc;
                    bf16_t* rowp = P + (size_t)(rowb + ai * 128 + m * 16) * INP + pn * 256 + wc * 32 + 4 * fq;
#pragma unroll
                    for (int bj = 0; bj < 2; ++bj)
#pragma unroll
                        for (int n = 0; n < 2; ++n) *(u32x2*)(rowp + bj * 128 + n * 16) = pk4(acc[ai][bj][m][n] * r);
                    asm volatile("" ::: "memory");
                }
        }
    }
};

struct EpiRes {
    static constexpr bool PERM = false, AFTER_DRAIN = false;
    const float* xin; float* xout; bf16_t* XB; float* ssq;
    __device__ __forceinline__ void operator()(const f32x4 (&acc)[2][2][4][2], const Unit& u, int wr, int wc, int fr, int fq) const {
        const int rowb = u.pm * 256 + wr * 64 + fr, colb = u.pn * 256 + wc * 32 + 4 * fq;
#pragma unroll
        for (int ai = 0; ai < 2; ++ai) {
            f32x4 xr[4][2][2];
#pragma unroll
            for (int m = 0; m < 4; ++m)
#pragma unroll
                for (int bj = 0; bj < 2; ++bj)
#pragma unroll
                    for (int n = 0; n < 2; ++n) xr[m][bj][n] = *(const GAS f32x4*)((const GAS float*)xin + (size_t)(rowb + ai * 128 + m * 16) * DM + colb + bj * 128 + n * 16);
#pragma unroll
            for (int m = 0; m < 4; ++m) {
                const int row = rowb + ai * 128 + m * 16; float q = 0.f;
#pragma unroll
                for (int bj = 0; bj < 2; ++bj)
#pragma unroll
                    for (int n = 0; n < 2; ++n) {
                        const size_t off = (size_t)row * DM + colb + bj * 128 + n * 16;
                        const f32x4 x = xr[m][bj][n] + acc[ai][bj][m][n];
                        *(GAS f32x4*)((GAS float*)xout + off) = x; *(GAS u32x2*)((GAS bf16_t*)XB + off) = pk4(x); q += dot4(x);
                    }
                q = fq_sum(q);
                if (fq == 0) ssq[(size_t)row * 32 + u.pn * 4 + wc] = q;
            }
            asm volatile("" ::: "memory");
        }
    }
};

struct EpiSwiglu {
    static constexpr bool PERM = false, AFTER_DRAIN = false;
    bf16_t* H; const float* ssq;
    __device__ __forceinline__ void operator()(const f32x4 (&acc)[2][2][4][2], const Unit& u, int wr, int wc, int fr, int fq) const {
        const int rowb = u.pm * 256 + wr * 64 + fr;
        float rs[2][4]; row_rstd(ssq, rowb, fq, rs);
#pragma unroll
        for (int ai = 0; ai < 2; ++ai)
#pragma unroll
            for (int m = 0; m < 4; ++m) {
                const float r = rs[ai][m];
                bf16_t* rowp = H + (size_t)(rowb + ai * 128 + m * 16) * DFF + u.pn * 128 + wc * 32 + 4 * fq;
#pragma unroll
                for (int n = 0; n < 2; ++n) {
                    const f32x4 g = acc[ai][0][m][n] * r, up = acc[ai][1][m][n] * r; f32x4 h;
#pragma unroll
                    for (int e = 0; e < 4; ++e) h[e] = g[e] * __builtin_amdgcn_rcpf(1.0f + __expf(-g[e])) * up[e];
                    *(u32x2*)(rowp + n * 16) = pk4(h);
                }
            }
    }
};

struct EpiPlain {
    static constexpr bool PERM = false, AFTER_DRAIN = false;
    bf16_t* O; int ldc;
    __device__ __forceinline__ void operator()(const f32x4 (&acc)[2][2][4][2], const Unit& u, int wr, int wc, int fr, int fq) const {
        const int rowb = u.pm * 256 + wr * 64 + fr;
#pragma unroll
        for (int ai = 0; ai < 2; ++ai)
#pragma unroll
            for (int m = 0; m < 4; ++m) {
                bf16_t* rowp = O + (size_t)(rowb + ai * 128 + m * 16) * ldc + u.pn * 256 + wc * 32 + 4 * fq;
#pragma unroll
                for (int bj = 0; bj < 2; ++bj)
#pragma unroll
                    for (int n = 0; n < 2; ++n) *(u32x2*)(rowp + bj * 128 + n * 16) = pk4(acc[ai][bj][m][n]);
            }
    }
};

__device__ __forceinline__ int in_map(int c) {
    if (c < 3072) return c;
    if (c < 4096) { const int cc = c - 3072, t = cc >> 8, cl = cc & 255, bj = cl >> 7, wc = (cl >> 5) & 3; return 3104 + 256 * t + 64 * wc + 32 * bj; }
    if (c < 5120) return c + 32;
    if (c == 5120) return 3072;
    return -1;
}
__device__ __forceinline__ int w13_map(int c) { const int t = c >> 8, cl = c & 255; return cl < 128 ? 128 * t + cl : DFF + 128 * t + (cl - 128); }

__device__ __forceinline__ void tr_item(const float* W, int ldw, int sc, const float* gain, bf16_t* WT, int K, int drow0, int k0, LAS float* scr, int lane) {
    if (sc < 0) {
        const int c = lane & 7;
#pragma unroll
        for (int j = 0; j < 4; ++j) { const int n = (lane >> 3) + 8 * j; *(u32x4*)(WT + (size_t)(drow0 + n) * K + k0 + 8 * c) = (u32x4){0u, 0u, 0u, 0u}; }
        return;
    }
    { const GAS float* wp = (const GAS float*)W + (size_t)(k0 + (lane >> 5)) * ldw + sc + (lane & 31); float w[32];
#pragma unroll
      for (int i = 0; i < 32; ++i) w[i] = wp[(size_t)(2 * i) * ldw];
      if (gain) { const GAS float* gp = (const GAS float*)gain + k0 + (lane >> 5);
#pragma unroll
          for (int i = 0; i < 32; ++i) w[i] *= gp[2 * i]; }
#pragma unroll
      for (int i = 0; i < 32; ++i) scr[(2 * i + (lane >> 5)) * 33 + (lane & 31)] = w[i]; }
    asm volatile("s_waitcnt lgkmcnt(0)" ::: "memory");
    const int c = lane & 7;
#pragma unroll
    for (int j = 0; j < 4; ++j) { const int n = (lane >> 3) + 8 * j; const LAS float* s = scr + (8 * c) * 33 + n;
        u32x4 o; o.x = cvt_pk_bf16(s[0 * 33], s[1 * 33]); o.y = cvt_pk_bf16(s[2 * 33], s[3 * 33]); o.z = cvt_pk_bf16(s[4 * 33], s[5 * 33]); o.w = cvt_pk_bf16(s[6 * 33], s[7 * 33]);
        *(u32x4*)(WT + (size_t)(drow0 + n) * K + k0 + 8 * c) = o; }
    asm volatile("s_waitcnt lgkmcnt(0)" ::: "memory");
}

struct Args { const float* in[22]; float* out; unsigned char* ws; int ph_lo, ph_hi; };

__device__ __forceinline__ void p0_prologue(const Args& a, LAS unsigned char* lds, int G) {
    const int tid = tidx(), lane = tid & 63, wave = tid >> 6;
    LAS float* scr = (LAS float*)(lds + wave * 16384);
    const int gw = blockIdx.x * NWAVES + wave, NGW = G * NWAVES;
    constexpr int I_IN = 32 * (INP / 32), I_OUT = 32 * 64, I_13 = 32 * (2 * DFF / 32), I_2 = (DFF / 64) * 64, I_MEM = 32 * 32, I_L = I_IN + I_OUT + I_13 + I_2 + I_MEM;
    unsigned char* ws = a.ws;
    for (int it = gw; it < DEPTH * I_L; it += NGW) {
        const int l = it / I_L; int r = it % I_L;
        if (r < I_IN) { const int nb = r % (INP / 32), kb = r / (INP / 32);
            tr_item(a.in[3] + (size_t)l * DM * INC, INC, in_map(nb * 32), a.in[2] + l * DM, (bf16_t*)(ws + WS_WIN + l * SZ_WIN), DM, nb * 32, kb * 64, scr, lane); continue; }
        r -= I_IN;
        if (r < I_OUT) { const int nb = r % 64, kb = r / 64;
            tr_item(a.in[18] + (size_t)l * DM * DM, DM, nb * 32, nullptr, (bf16_t*)(ws + WS_WOUT + l * SZ_WOUT), DM, nb * 32, kb * 64, scr, lane); continue; }
        r -= I_OUT;
        if (r < I_13) { const int nb = r % (2 * DFF / 32), kb = r / (2 * DFF / 32);
            tr_item(a.in[20] + (size_t)l * DM * 2 * DFF, 2 * DFF, w13_map(nb * 32), a.in[19] + l * DM, (bf16_t*)(ws + WS_W13 + l * SZ_W13), DM, nb * 32, kb * 64, scr, lane); continue; }
        r -= I_13;
        if (r < I_2) { const int nb = r % 64, kb = r / 64;
            tr_item(a.in[21] + (size_t)l * DFF * DM, DM, nb * 32, nullptr, (bf16_t*)(ws + WS_W2 + l * SZ_W2), DFF, nb * 32, kb * 64, scr, lane); continue; }
        r -= I_2;
        { const int nb = r % 32, kb = r / 32;
            tr_item(a.in[14] + (size_t)l * DM * 1024, 1024, nb * 32, a.in[13] + l * DM, (bf16_t*)(ws + WS_WMEM), DM, l * 1024 + nb * 32, kb * 64, scr, lane); }
    }
    for (int idx = gw * 64 + lane; idx < DEPTH * 2 * 512; idx += NGW * 64) {
        const int dd = idx & 511, dir = (idx >> 9) & 1, ll = idx >> 10;
        const GAS float* src = (const GAS float*)a.in[dir ? 6 : 4] + (size_t)ll * 16 * 512 + dd;
        u32x4 w0, w1;
        w0.x = cvt_pk_bf16(src[0 * 512], src[1 * 512]); w0.y = cvt_pk_bf16(src[2 * 512], src[3 * 512]); w0.z = cvt_pk_bf16(src[4 * 512], src[5 * 512]); w0.w = cvt_pk_bf16(src[6 * 512], src[7 * 512]);
        w1.x = cvt_pk_bf16(src[8 * 512], src[9 * 512]); w1.y = cvt_pk_bf16(src[10 * 512], src[11 * 512]); w1.z = cvt_pk_bf16(src[12 * 512], src[13 * 512]); w1.w = cvt_pk_bf16(src[14 * 512], src[15 * 512]);
        GAS u32x4* dst = (GAS u32x4*)(ws + WS_WG2T + (size_t)idx * 64);
        dst[0] = w0; dst[1] = w1; dst[2] = (u32x4){0u, 0u, 0u, 0u}; dst[3] = (u32x4){0u, 0u, 0u, 0u};
    }
    bf16_t* XB = (bf16_t*)(ws + WS_XB); float* SSQ = (float*)(ws + WS_SSQ); bf16_t* MEMN = (bf16_t*)(ws + WS_MEMN);
    for (int row = gw; row < MTOK + BATCH * MEMT; row += NGW) {
        const bool isx = row < MTOK; const int rr = isx ? row : row - MTOK;
        const f32x4* xr = (const f32x4*)((isx ? a.in[0] : a.in[1]) + (size_t)rr * DM) + lane;
        f32x4 v[8]; float s = 0.f;
#pragma unroll
        for (int j = 0; j < 8; ++j) { v[j] = xr[64 * j]; s += dot4(v[j]); }
        s = wave_sum(s);
        float sc = 1.0f;
        if (isx) { if (lane < 32) SSQ[(size_t)rr * 32 + lane] = lane == 0 ? s : 0.f; }
        else sc = rsqrtf(s * (1.0f / DM) + EPS);
        u32x2* o = (u32x2*)((isx ? XB : MEMN) + (size_t)rr * DM) + lane;
#pragma unroll
        for (int j = 0; j < 8; ++j) o[64 * j] = pk4(v[j] * sc);
    }
}

__device__ __forceinline__ void memprep(const Args& a, int G) {
    const int lane = tidx() & 63, wave = tidx() >> 6;
    const int gw = blockIdx.x * NWAVES + wave, NGW = G * NWAVES;
    const bf16_t* MKV = (const bf16_t*)(a.ws + WS_MKV); bf16_t* KM = (bf16_t*)(a.ws + WS_KM); bf16_t* VMT = (bf16_t*)(a.ws + WS_VMT);
    for (int it = gw; it < DEPTH * BATCH * 4 * MEMT; it += NGW) {
        const int key = it & 255, h = (it >> 8) & 3, b = (it >> 10) & 1, l = it >> 11;
        const bf16_t* src = MKV + (size_t)(b * 256 + key) * 4096 + l * 1024 + h * 128 + 2 * lane;
        const unsigned kw = *(const unsigned*)src, vw = *(const unsigned*)(src + 512);
        const float k0 = bflo(kw), k1 = bfhi(kw);
        const float ss = wave_sum(k0 * k0 + k1 * k1);
        const float r = rsqrtf(ss * (1.0f / 128.0f) + EPS) * 0.08838834764831845f;
        const float* gk = a.in[16] + l * 128 + 2 * lane; const float* gq = a.in[15] + l * 128 + 2 * lane;
        const size_t hb = (size_t)((l * 2 + b) * 4 + h) * 32768;
        *(unsigned*)(KM + hb + key * 128 + 2 * lane) = cvt_pk_bf16(k0 * r * gk[0] * gq[0], k1 * r * gk[1] * gq[1]);
        VMT[hb + (size_t)(2 * lane) * 256 + key] = (bf16_t)(vw & 0xffffu);
        VMT[hb + (size_t)(2 * lane + 1) * 256 + key] = (bf16_t)(vw >> 16);
    }
}

template <int D, bool IS_NA>
__device__ __forceinline__ void attn16(const bf16_t* qrow, const bf16_t* kbase, long kstride, int key0, int krstep,
                                       const bf16_t* vtbase, long vtstride, int vkey0,
                                       const LAS float* rpbh, int r, int rs, int j, int kc0,
                                       const float* ogain, bf16_t* y0, int fr, int fq) {
    bf16x8 qf[D / 32];
#pragma unroll
    for (int ks = 0; ks < D / 32; ++ks) qf[ks] = *(const GAS bf16x8*)((const GAS bf16_t*)qrow + 32 * ks + 8 * fq);
    float qscale = 1.0f;
    if (!IS_NA) {
        float ss = 0.f;
#pragma unroll
        for (int ks = 0; ks < D / 32; ++ks) { const u32x4 w = __builtin_bit_cast(u32x4, qf[ks]);
#pragma unroll
            for (int e = 0; e < 4; ++e) { const float lo = bflo(w[e]), hi = bfhi(w[e]); ss += lo * lo + hi * hi; } }
        ss = fq_sum(ss);
        qscale = rsqrtf(ss * (1.0f / D) + EPS);
    }
    f32x4 s[16];
    const int kro = 8 * (fr >> 2) + (fr & 3);
    constexpr int NK = D / 32, GT = 8 / NK;
    const GAS bf16_t* kb0 = (const GAS bf16_t*)kbase + (long)(key0 + kro) * kstride + 8 * fq;
    bf16x8 kf[2][GT][NK];
#define ATT_LDK(buf, g) do { _Pragma("unroll") for (int tt_ = 0; tt_ < GT; ++tt_) { const int t_ = (g) * GT + tt_, kr_ = t_ >> 1, u_ = t_ & 1; \
        const GAS bf16_t* kp_ = kb0 + (long)(kr_ * krstep + 4 * u_) * kstride; \
        _Pragma("unroll") for (int ks_ = 0; ks_ < NK; ++ks_) kf[buf][tt_][ks_] = *(const GAS bf16x8*)(kp_ + 32 * ks_); } } while (0)
    ATT_LDK(0, 0);
#pragma unroll
    for (int g = 0; g < 16 / GT; ++g) {
        if (g + 1 < 16 / GT) ATT_LDK((g + 1) & 1, g + 1);
#pragma unroll
        for (int tt = 0; tt < GT; ++tt) { f32x4 acc = (f32x4){0.f, 0.f, 0.f, 0.f};
#pragma unroll
            for (int ks = 0; ks < NK; ++ks) acc = mfma16(kf[g & 1][tt][ks], qf[ks], acc);
            s[g * GT + tt] = acc; }
    }
#undef ATT_LDK
    float mx = -INFINITY;
    if (IS_NA) {
        const int qcol = 16 * j + fr; const int cs = min(max(qcol - 8, 0), 48);
#pragma unroll
        for (int t = 0; t < 16; ++t) {
            const int kr = t >> 1, u = t & 1, dr = rs + kr - r + 7;
#pragma unroll
            for (int i = 0; i < 4; ++i) {
                const int kcol = kc0 + 8 * fq + 4 * u + i; const bool valid = kcol >= cs && kcol < cs + 16;
                const int dc = min(max(kcol - qcol + 15, 0), 30);
                const float v = valid ? s[t][i] + rpbh[dr * 31 + dc] : -INFINITY;
                s[t][i] = v; mx = fmaxf(mx, v);
            }
        }
    } else {
#pragma unroll
        for (int t = 0; t < 16; ++t)
#pragma unroll
            for (int i = 0; i < 4; ++i) { const float v = s[t][i] * qscale; s[t][i] = v; mx = fmaxf(mx, v); }
    }
    mx = fq_max(mx);
    float sum = 0.f;
#pragma unroll
    for (int t = 0; t < 16; ++t)
#pragma unroll
        for (int i = 0; i < 4; ++i) { const float p = __expf(s[t][i] - mx); s[t][i] = p; sum += p; }
    sum = fq_sum(sum);
    const float inv = 1.0f / sum;
    f32x4 o[D / 16];
#pragma unroll
    for (int nd = 0; nd < D / 16; ++nd) o[nd] = (f32x4){0.f, 0.f, 0.f, 0.f};
    const GAS bf16_t* vb0 = (const GAS bf16_t*)vtbase + (long)fr * vtstride + vkey0 + 8 * fq;
    bf16x8 vf[2][D / 16];
#pragma unroll
    for (int nd = 0; nd < D / 16; ++nd) vf[0][nd] = *(const GAS bf16x8*)(vb0 + (long)(16 * nd) * vtstride);
#pragma unroll
    for (int kr = 0; kr < 8; ++kr) {
        if (kr + 1 < 8) {
#pragma unroll
            for (int nd = 0; nd < D / 16; ++nd) vf[(kr + 1) & 1][nd] = *(const GAS bf16x8*)(vb0 + (kr + 1) * krstep + (long)(16 * nd) * vtstride); }
        const bf16x8 pa = pk8(s[2 * kr] * inv, s[2 * kr + 1] * inv);
#pragma unroll
        for (int nd = 0; nd < D / 16; ++nd) o[nd] = mfma16(pa, vf[kr & 1][nd], o[nd]);
    }
    float ro[4];
#pragma unroll
    for (int i = 0; i < 4; ++i) { float ss = 0.f;
#pragma unroll
        for (int nd = 0; nd < D / 16; ++nd) ss += o[nd][i] * o[nd][i];
        ss = fr_sum(ss); ro[i] = rsqrtf(ss * (1.0f / D) + EPS); }
#pragma unroll
    for (int nd = 0; nd < D / 16; ++nd) { const float g = ogain[16 * nd + fr];
#pragma unroll
        for (int i = 0; i < 4; ++i) y0[(size_t)(4 * fq + i) * DM + 16 * nd + fr] = f2bf(o[nd][i] * ro[i] * g); }
}

constexpr int GL_CUMF = 8192, GL_CUMB = GL_CUMF + 32768, GL_VTA = GL_CUMB + 32768, GL_KTF = GL_VTA + 36864, GL_KTB = GL_KTF + 18432;
constexpr int GL_G = 0, GL_CUM = 4096, GL_VT = GL_CUM + 32768, GL_KT = GL_VT + 36864, GL_QE = GL_KT, GL_KE = GL_QE + 17408, GL_RED = GL_KE + 17408;
constexpr int VTS = 72, QES = 136;

__device__ __forceinline__ void gla_cum(const Args& a, LAS unsigned char* lds, int l, int h, int t0, int dir) {
    const int tid = tidx();
    LAS float* Gs = (LAS float*)(lds + GL_G); LAS float* CUM = (LAS float*)(lds + GL_CUM);
    const bf16_t* P = (const bf16_t*)(a.ws + WS_P);
    if (tid < 128) { const int s = tid >> 1, hf = tid & 1;
        const u32x4 w = *(const u32x4*)(P + (size_t)(t0 + s) * INP + C_GG + 16 * dir + 8 * hf);
        LAS float* g = Gs + s * 16 + 8 * hf;
#pragma unroll
        for (int e = 0; e < 4; ++e) { g[2 * e] = bflo(w[e]); g[2 * e + 1] = bfhi(w[e]); } }
    const int d = tid & 127, sg = tid >> 7;
    const float* wg = a.in[dir ? 6 : 4] + (size_t)l * 16 * 512 + 128 * h + d;
    float w[16];
#pragma unroll
    for (int jj = 0; jj < 16; ++jj) w[jj] = wg[jj * 512];
    const float bias = a.in[dir ? 7 : 5][l * 512 + 128 * h + d];
    __syncthreads();
#pragma unroll 4
    for (int i = 0; i < 16; ++i) { const int s = sg * 16 + i; const LAS f32x4* g4 = (const LAS f32x4*)(Gs + s * 16);
        float z = bias;
#pragma unroll
        for (int q = 0; q < 4; ++q) { const f32x4 g = g4[q]; z += g[0] * w[4 * q] + g[1] * w[4 * q + 1] + g[2] * w[4 * q + 2] + g[3] * w[4 * q + 3]; }
        const float ls = fminf(z, 0.f) - __logf(1.0f + __expf(-fabsf(z)));
        CUM[s * 128 + d] = ls * (1.0f / 16.0f); }
    __syncthreads();
    if (tid < 256) { const int hf = tid >> 7; float run = 0.f;
#pragma unroll 8
        for (int p = 0; p < 32; ++p) { const int pp = 32 * hf + p, s = dir ? 63 - pp : pp; run += CUM[s * 128 + d]; CUM[s * 128 + d] = run; } }
    __syncthreads();
    { const int sl = dir ? 32 : 31; const float tot = CUM[sl * 128 + d];
#pragma unroll
      for (int i = 0; i < 8; ++i) { const int pp = 32 + 8 * sg + i, s = dir ? 63 - pp : pp; CUM[s * 128 + d] += tot; } }
    __syncthreads();
}

__device__ __forceinline__ void gla_vt(const Args& a, LAS unsigned char* lds, int h, int t0) {
    const int tid = tidx(), e = tid & 255, sg = tid >> 8;
    const bf16_t* P = (const bf16_t*)(a.ws + WS_P) + (size_t)t0 * INP + C_GV + 256 * h + e;
    LAS bf16_t* VT = (LAS bf16_t*)(lds + GL_VT);
#pragma unroll
    for (int it = 0; it < 4; ++it) { const int s0 = 8 * (sg + 2 * it); unsigned short v[8];
#pragma unroll
        for (int i = 0; i < 8; ++i) v[i] = P[(size_t)(s0 + i) * INP];
        u32x4 w; w.x = v[0] | ((unsigned)v[1] << 16); w.y = v[2] | ((unsigned)v[3] << 16); w.z = v[4] | ((unsigned)v[5] << 16); w.w = v[6] | ((unsigned)v[7] << 16);
        *(LAS u32x4*)(VT + e * VTS + s0) = w; }
}

struct GlaVtRegs { unsigned short v[4][8]; };
__device__ __forceinline__ void gla_vt_load(const Args& a, GlaVtRegs& R, int h, int t0) {
    const int tid = tidx(), e = tid & 255, sg = tid >> 8;
    const GAS bf16_t* P = (const GAS bf16_t*)(a.ws + WS_P) + (size_t)t0 * INP + C_GV + 256 * h + e;
#pragma unroll
    for (int it = 0; it < 4; ++it)
#pragma unroll
        for (int i = 0; i < 8; ++i) R.v[it][i] = P[(size_t)(8 * (sg + 2 * it) + i) * INP];
}
__device__ __forceinline__ void gla_vt_store(const GlaVtRegs& R, LAS bf16_t* VT) {
    const int tid = tidx(), e = tid & 255, sg = tid >> 8;
#pragma unroll
    for (int it = 0; it < 4; ++it) { const int s0 = 8 * (sg + 2 * it);
        u32x4 w; w.x = R.v[it][0] | ((unsigned)R.v[it][1] << 16); w.y = R.v[it][2] | ((unsigned)R.v[it][3] << 16); w.z = R.v[it][4] | ((unsigned)R.v[it][5] << 16); w.w = R.v[it][6] | ((unsigned)R.v[it][7] << 16);
        *(LAS u32x4*)(VT + e * VTS + s0) = w; }
}

struct GlaGateRegs { bf16x8 af, ab, wfr[4], wbr[4]; float bfv[4], bbv[4]; };
__device__ __forceinline__ void gla_gate_load(const Args& a, GlaGateRegs& R, int l, int h, int t0, int wave, int fr, int fq) {
    const int mt = wave & 3, dh = wave >> 2;
    const GAS bf16_t* gp = (const GAS bf16_t*)(a.ws + WS_P) + (size_t)(t0 + 16 * mt + fr) * INP + C_GG;
    R.af = *(const GAS bf16x8*)(gp + 8 * fq); R.ab = *(const GAS bf16x8*)(gp + ((8 * fq + 16) & 31));
    const GAS bf16_t* wt = (const GAS bf16_t*)(a.ws + WS_WG2T) + ((size_t)(l * 2) * 512 + 128 * h + 64 * dh + fr) * 32 + 8 * fq;
#pragma unroll
    for (int dt = 0; dt < 4; ++dt) { R.wfr[dt] = *(const GAS bf16x8*)(wt + dt * 16 * 32); R.wbr[dt] = *(const GAS bf16x8*)(wt + 512 * 32 + dt * 16 * 32);
        R.bfv[dt] = a.in[5][l * 512 + 128 * h + 64 * dh + 16 * dt + fr]; R.bbv[dt] = a.in[7][l * 512 + 128 * h + 64 * dh + 16 * dt + fr]; }
}
__device__ __forceinline__ void gla_gate_compute(const GlaGateRegs& R, LAS float* CF, LAS float* CB, int wave, int fr, int fq) {
    const int mt = wave & 3, dh = wave >> 2;
#pragma unroll
    for (int dt = 0; dt < 4; ++dt) {
        const f32x4 zf = mfma16(R.af, R.wfr[dt], (f32x4){0.f, 0.f, 0.f, 0.f}), zb = mfma16(R.ab, R.wbr[dt], (f32x4){0.f, 0.f, 0.f, 0.f});
        const int dcol = 64 * dh + 16 * dt + fr;
#pragma unroll
        for (int i = 0; i < 4; ++i) { const int srow = 16 * mt + 4 * fq + i; const float vf = zf[i] + R.bfv[dt], vb = zb[i] + R.bbv[dt];
            CF[srow * 128 + dcol] = (fminf(vf, 0.f) - __logf(1.0f + __expf(-fabsf(vf)))) * (1.0f / 16.0f);
            CB[srow * 128 + dcol] = (fminf(vb, 0.f) - __logf(1.0f + __expf(-fabsf(vb)))) * (1.0f / 16.0f); }
    }
}

__device__ __forceinline__ void gla_a_unit(const Args& a, LAS unsigned char* lds, int l, int unit) {
    const int tid = tidx(), lane = tid & 63, wave = tid >> 6, fr = lane & 15, fq = lane >> 4;
    const int n = unit & 127, h = (unit >> 7) & 3, b = unit >> 9, t0 = b * SEQ + n * 64;
    const int d = tid & 127, sg = tid >> 7;
    const GAS bf16_t* P = (const GAS bf16_t*)(a.ws + WS_P);
    LAS float* Gs = (LAS float*)(lds + GL_G); LAS float* CF = (LAS float*)(lds + GL_CUMF); LAS float* CB = (LAS float*)(lds + GL_CUMB);
    LAS bf16_t* VT = (LAS bf16_t*)(lds + GL_VTA); LAS bf16_t* KTF = (LAS bf16_t*)(lds + GL_KTF); LAS bf16_t* KTB = (LAS bf16_t*)(lds + GL_KTB);
    GAS bf16_t* ST = (GAS bf16_t*)(a.ws + WS_ST); GAS float* DEC = (GAS float*)(a.ws + WS_DEC);
    GlaGateRegs GR; gla_gate_load(a, GR, l, h, t0, wave, fr, fq);
    GlaVtRegs VR; gla_vt_load(a, VR, h, t0);
    __syncthreads();
    gla_vt_store(VR, VT);
    unsigned short kv[2][8];
    { const GAS bf16_t* kp = P + (size_t)t0 * INP + C_GK + 128 * h + d;
#pragma unroll
      for (int it = 0; it < 2; ++it)
#pragma unroll
          for (int i = 0; i < 8; ++i) kv[it][i] = kp[(size_t)(8 * (sg + 4 * it) + i) * INP]; }
    gla_gate_compute(GR, CF, CB, wave, fr, fq);
    __syncthreads();
    { const int dir = tid >> 8, hf = (tid >> 7) & 1; LAS float* C = dir ? CB : CF; float run = 0.f;
#pragma unroll 8
      for (int p = 0; p < 32; ++p) { const int pp = 32 * hf + p, s = dir ? 63 - pp : pp; run += C[s * 128 + d]; C[s * 128 + d] = run; } }
    __syncthreads();
    { const float tf = CF[31 * 128 + d], tb = CB[32 * 128 + d];
#pragma unroll
      for (int i = 0; i < 8; ++i) { const int pp = 32 + 8 * sg + i; CF[pp * 128 + d] += tf; CB[(63 - pp) * 128 + d] += tb; } }
    __syncthreads();
    { const float lf = CF[63 * 128 + d], lb = CB[d];
#pragma unroll
      for (int it = 0; it < 2; ++it) { const int s0 = 8 * (sg + 4 * it); float vf[8], vb[8];
#pragma unroll
          for (int i = 0; i < 8; ++i) { const float k = bf2f(kv[it][i]); vf[i] = k * __expf(lf - CF[(s0 + i) * 128 + d]); vb[i] = k * __expf(lb - CB[(s0 + i) * 128 + d]); }
          u32x4 w; w.x = cvt_pk_bf16(vf[0], vf[1]); w.y = cvt_pk_bf16(vf[2], vf[3]); w.z = cvt_pk_bf16(vf[4], vf[5]); w.w = cvt_pk_bf16(vf[6], vf[7]);
          *(LAS u32x4*)(KTF + d * VTS + s0) = w;
          w.x = cvt_pk_bf16(vb[0], vb[1]); w.y = cvt_pk_bf16(vb[2], vb[3]); w.z = cvt_pk_bf16(vb[4], vb[5]); w.w = cvt_pk_bf16(vb[6], vb[7]);
          *(LAS u32x4*)(KTB + d * VTS + s0) = w; }
      if (tid < 128) { DEC[((size_t)unit * 2 + 0) * 128 + d] = __expf(lf); DEC[((size_t)unit * 2 + 1) * 128 + d] = __expf(lb); }
    }
    __syncthreads();
    bf16x8 vb[2][2];
#pragma unroll
    for (int et = 0; et < 2; ++et)
#pragma unroll
        for (int ks = 0; ks < 2; ++ks) vb[et][ks] = *(const LAS bf16x8*)(VT + (32 * wave + 16 * et + fr) * VTS + 32 * ks + 8 * fq);
#pragma unroll
    for (int dir = 0; dir < 2; ++dir) { const LAS bf16_t* KT = dir ? KTB : KTF; GAS bf16_t* stp = ST + ((size_t)unit * 2 + dir) * 32768;
#pragma unroll
        for (int dt = 0; dt < 8; ++dt) {
            bf16x8 ka[2];
#pragma unroll
            for (int ks = 0; ks < 2; ++ks) ka[ks] = *(const LAS bf16x8*)(KT + (16 * dt + fr) * VTS + 32 * ks + 8 * fq);
#pragma unroll
            for (int et = 0; et < 2; ++et) { f32x4 acc = (f32x4){0.f, 0.f, 0.f, 0.f};
                acc = mfma16(ka[0], vb[et][0], acc); acc = mfma16(ka[1], vb[et][1], acc);
                *(GAS u32x2*)(stp + (size_t)(((2 * wave + et) * 8 + dt) * 256 + fr * 16 + 4 * fq)) = pk4(acc); }
        } }
}

__device__ __forceinline__ void gla_scan(const Args& a, int G) {
    const GAS bf16_t* ST = (const GAS bf16_t*)(a.ws + WS_ST); GAS bf16_t* ST2 = (GAS bf16_t*)(a.ws + WS_ST2); const GAS float* DEC = (const GAS float*)(a.ws + WS_DEC);
    for (int gid = blockIdx.x * NTHR + tidx(); gid < 16 * 8192; gid += G * NTHR) {
        const int seq = gid >> 13, off = (gid & 8191) * 4, dir = seq & 1, bh = seq >> 1, d = 16 * ((off >> 8) & 7) + (off & 15);
        f32x4 st = (f32x4){0.f, 0.f, 0.f, 0.f};
        for (int s0 = 0; s0 < 128; s0 += 8) {
            u32x2 kv[8]; f32x4 dc[8];
#pragma unroll
            for (int j = 0; j < 8; ++j) { const int n = dir ? 127 - (s0 + j) : (s0 + j); const size_t u2 = (size_t)(bh * 128 + n) * 2 + dir;
                kv[j] = *(const GAS u32x2*)(ST + u2 * 32768 + off); dc[j] = *(const GAS f32x4*)(DEC + u2 * 128 + d); }
#pragma unroll
            for (int j = 0; j < 8; ++j) { const int n = dir ? 127 - (s0 + j) : (s0 + j); const size_t u2 = (size_t)(bh * 128 + n) * 2 + dir;
                *(GAS u32x2*)(ST2 + u2 * 32768 + off) = pk4(st);
                st[0] = dc[j][0] * st[0] + bflo(kv[j].x); st[1] = dc[j][1] * st[1] + bfhi(kv[j].x); st[2] = dc[j][2] * st[2] + bflo(kv[j].y); st[3] = dc[j][3] * st[3] + bfhi(kv[j].y); }
        }
    }
}

constexpr int GL2_G = 0, GL2_CF = 8192, GL2_CB = GL2_CF + 32768, GL2_VT = GL2_CB + 32768, GL2_QE = GL2_VT + 36864, GL2_KE = GL2_QE + 17408;
__device__ __forceinline__ void gla_c_unit(const Args& a, LAS unsigned char* lds, int l, int unit) {
    const int tid = tidx(), lane = tid & 63, wave = tid >> 6, fr = lane & 15, fq = lane >> 4;
    const int n = unit & 127, h = (unit >> 7) & 3, b = unit >> 9, t0 = b * SEQ + n * 64;
    const int tt = wave & 3, eh = wave >> 2, d = tid & 127, sg = tid >> 7;
    const GAS bf16_t* P = (const GAS bf16_t*)(a.ws + WS_P);
    LAS float* Gs = (LAS float*)(lds + GL2_G); LAS float* CF = (LAS float*)(lds + GL2_CF); LAS float* CB = (LAS float*)(lds + GL2_CB);
    LAS bf16_t* VT = (LAS bf16_t*)(lds + GL2_VT); LAS bf16_t* QE = (LAS bf16_t*)(lds + GL2_QE); LAS bf16_t* KE = (LAS bf16_t*)(lds + GL2_KE); LAS float* RED = (LAS float*)(lds + GL2_G);
    const GAS bf16_t* ST = (const GAS bf16_t*)(a.ws + WS_ST2);
    f32x4 o[2][4];
#pragma unroll
    for (int et = 0; et < 2; ++et)
#pragma unroll
        for (int tq = 0; tq < 4; ++tq) o[et][tq] = (f32x4){0.f, 0.f, 0.f, 0.f};
    bf16x8 sf[2][2][4];
    const GAS bf16x8* sp0 = (const GAS bf16x8*)(ST + (size_t)unit * 2 * 32768 + (size_t)(2 * wave * 8 + (fq >> 1)) * 256 + fr * 16 + 8 * (fq & 1));
    {
#pragma unroll
      for (int et = 0; et < 2; ++et)
#pragma unroll
          for (int ks = 0; ks < 4; ++ks) sf[0][et][ks] = sp0[et * 256 + ks * 64]; }
    u32x2 rw[2][4];
    const int sb = tid >> 3, d0 = 16 * (tid & 7);
    u32x4 qw[2], kw[2];
    { const GAS u32x4* qp = (const GAS u32x4*)(P + (size_t)(t0 + sb) * INP + C_GQ + 128 * h + d0); const GAS u32x4* kp = (const GAS u32x4*)(P + (size_t)(t0 + sb) * INP + C_GK + 128 * h + d0);
      qw[0] = qp[0]; qw[1] = qp[1]; kw[0] = kp[0]; kw[1] = kp[1]; }
    GlaGateRegs GR; gla_gate_load(a, GR, l, h, t0, wave, fr, fq);
    GlaVtRegs VR; gla_vt_load(a, VR, h, t0);
    __syncthreads();
    gla_vt_store(VR, VT);
    gla_gate_compute(GR, CF, CB, wave, fr, fq);
    __syncthreads();
    { const int dir = tid >> 8, hf = (tid >> 7) & 1; LAS float* C = dir ? CB : CF; float run = 0.f;
#pragma unroll 8
      for (int p = 0; p < 32; ++p) { const int pp = 32 * hf + p, s = dir ? 63 - pp : pp; run += C[s * 128 + d]; C[s * 128 + d] = run; } }
    __syncthreads();
    { const float tf = CF[31 * 128 + d], tb = CB[32 * 128 + d];
#pragma unroll
      for (int i = 0; i < 8; ++i) { const int pp = 32 + 8 * sg + i; CF[pp * 128 + d] += tf; CB[(63 - pp) * 128 + d] += tb; } }
    __syncthreads();
    const int t = 16 * tt + fr;
#pragma unroll
    for (int dir = 0; dir < 2; ++dir) {
        { const LAS float* C = dir ? CB : CF;
#pragma unroll
          for (int c = 0; c < 2; ++c) { const LAS f32x4* cp = (const LAS f32x4*)(C + sb * 128 + d0 + 8 * c); const f32x4 c0 = cp[0], c1 = cp[1];
              const float cv[8] = {c0[0], c0[1], c0[2], c0[3], c1[0], c1[1], c1[2], c1[3]}; u32x4 qo, ko;
#pragma unroll
              for (int e = 0; e < 4; ++e) {
                  qo[e] = cvt_pk_bf16(bflo(qw[c][e]) * __expf(cv[2 * e]), bfhi(qw[c][e]) * __expf(cv[2 * e + 1]));
                  ko[e] = cvt_pk_bf16(bflo(kw[c][e]) * __expf(-cv[2 * e]), bfhi(kw[c][e]) * __expf(-cv[2 * e + 1])); }
              *(LAS u32x4*)(QE + sb * QES + d0 + 8 * c) = qo; *(LAS u32x4*)(KE + sb * QES + d0 + 8 * c) = ko; } }
        __syncthreads();
        bf16x8 pb[4][2];
#pragma unroll
        for (int sgi = 0; sgi < 2; ++sgi) {
            bf16x8 kf[2][4];
#pragma unroll
            for (int u = 0; u < 2; ++u) { const int srow = 32 * sgi + 8 * (fr >> 2) + (fr & 3) + 4 * u;
#pragma unroll
                for (int ks = 0; ks < 4; ++ks) kf[u][ks] = *(const LAS bf16x8*)(KE + srow * QES + 32 * ks + 8 * fq); }
#pragma unroll
            for (int tq = 0; tq < 4; ++tq) { const int tcol = 16 * tq + fr; bf16x8 qf[4]; f32x4 sc[2];
#pragma unroll
                for (int ks = 0; ks < 4; ++ks) qf[ks] = *(const LAS bf16x8*)(QE + (16 * tq + fr) * QES + 32 * ks + 8 * fq);
#pragma unroll
                for (int u = 0; u < 2; ++u) { f32x4 acc = (f32x4){0.f, 0.f, 0.f, 0.f};
#pragma unroll
                    for (int ks = 0; ks < 4; ++ks) acc = mfma16(kf[u][ks], qf[ks], acc);
#pragma unroll
                    for (int i = 0; i < 4; ++i) { const int srow = 32 * sgi + 8 * fq + 4 * u + i; const bool keep = dir ? (srow > tcol) : (srow <= tcol); acc[i] = keep ? acc[i] : 0.f; }
                    sc[u] = acc; }
                pb[tq][sgi] = pk8(sc[0], sc[1]); } }
        if (dir == 0) {
#pragma unroll
            for (int et = 0; et < 2; ++et)
#pragma unroll
                for (int ks = 0; ks < 4; ++ks) sf[1][et][ks] = sp0[4096 + et * 256 + ks * 64];
        } else {
            const GAS bf16_t* rp = P + (size_t)(t0 + fr) * INP + C_GR + 256 * h + 32 * wave + 4 * fq;
#pragma unroll
            for (int et = 0; et < 2; ++et)
#pragma unroll
                for (int tq = 0; tq < 4; ++tq) rw[et][tq] = *(const GAS u32x2*)(rp + (size_t)(16 * tq) * INP + 16 * et); }
        bf16x8 vf[2][2];
#pragma unroll
        for (int et = 0; et < 2; ++et)
#pragma unroll
            for (int sgi = 0; sgi < 2; ++sgi) vf[et][sgi] = *(const LAS bf16x8*)(VT + (32 * wave + 16 * et + fr) * VTS + 32 * sgi + 8 * fq);
#pragma unroll
        for (int tq = 0; tq < 4; ++tq) { bf16x8 qf[4];
#pragma unroll
            for (int ks = 0; ks < 4; ++ks) qf[ks] = *(const LAS bf16x8*)(QE + (16 * tq + fr) * QES + 32 * ks + 8 * fq);
#pragma unroll
            for (int et = 0; et < 2; ++et) { f32x4 acc = o[et][tq];
#pragma unroll
                for (int sgi = 0; sgi < 2; ++sgi) acc = mfma16(vf[et][sgi], pb[tq][sgi], acc);
#pragma unroll
                for (int ks = 0; ks < 4; ++ks) acc = mfma16(sf[dir][et][ks], qf[ks], acc);
                o[et][tq] = acc; } }
        if (dir == 0) __syncthreads();
    }
#pragma unroll
    for (int tq = 0; tq < 4; ++tq) { float ss = dot4(o[0][tq]) + dot4(o[1][tq]); ss = fq_sum(ss); if (fq == 0) RED[wave * 64 + 16 * tq + fr] = ss; }
    __syncthreads();
    const float* gn = a.in[8] + l * 1024 + 256 * h; GAS bf16_t* Y = (GAS bf16_t*)(a.ws + WS_Y);
#pragma unroll
    for (int tq = 0; tq < 4; ++tq) { const int t = 16 * tq + fr; float tot = 0.f;
#pragma unroll
        for (int w8 = 0; w8 < 8; ++w8) tot += RED[w8 * 64 + t];
        const float rstd = rsqrtf(tot * (1.0f / 256.0f) + EPS);
#pragma unroll
        for (int et = 0; et < 2; ++et) { const int e = 32 * wave + 16 * et + 4 * fq;
            const f32x4 g = *(const f32x4*)(gn + e);
            const float r4[4] = {bflo(rw[et][tq].x), bfhi(rw[et][tq].x), bflo(rw[et][tq].y), bfhi(rw[et][tq].y)}; f32x4 y;
#pragma unroll
            for (int i = 0; i < 4; ++i) y[i] = o[et][tq][i] * rstd * g[i] * (r4[i] * __builtin_amdgcn_rcpf(1.0f + __expf(-r4[i])));
            *(GAS u32x2*)(Y + (size_t)(t0 + t) * DM + 256 * h + e) = pk4(y); } }
}

constexpr int NA_RPB = 147456, NA_VL = 73728;
__device__ __forceinline__ void na_attn_block(const Args& a, LAS unsigned char* lds, int l, int u) {
    const int tid = tidx(), lane = tid & 63, wave = tid >> 6, fr = lane & 15, fq = lane >> 4;
    const int b = u >> 9, h = (u >> 6) & 7, r0 = 2 * (u & 63), r = r0 + (wave >> 2), j = wave & 3;
    const int rs0 = min(max(r0 - 4, 0), 120), rs = min(max(r - 4, 0), 120), krw = rs - rs0, kc0 = min(max(16 * j - 8, 0), 32);
    const int tq0 = b * SEQ + r * 64 + 16 * j;
    const GAS bf16_t* P = (const GAS bf16_t*)(a.ws + WS_P);
    LAS unsigned char* KL = lds; LAS unsigned char* VL = lds + NA_VL; LAS float* rpbh = (LAS float*)(lds + NA_RPB);
    bf16x8 qf[2];
    { const GAS bf16_t* qrow = P + (size_t)(tq0 + fr) * INP + C_NQ + 64 * h;
      qf[0] = *(const GAS bf16x8*)(qrow + 8 * fq); qf[1] = *(const GAS bf16x8*)(qrow + 32 + 8 * fq); }
    u32x4 kst[9], vst[9];
    { const GAS bf16_t* vg = (const GAS bf16_t*)(a.ws + WS_NVT) + (size_t)(b * 512 + 64 * h) * 8192 + rs0 * 64;
#pragma unroll
      for (int i = 0; i < 9; ++i) { const int ci = tid + 512 * i;
          { const int kk = ci >> 3, ch = ci & 7, trow = min(rs0 + (kk >> 6), 127);
            kst[i] = *(const GAS u32x4*)(P + (size_t)(b * SEQ + trow * 64 + (kk & 63)) * INP + C_NK + 64 * h + 8 * ch); }
          { const int dd = ci / 72, c = ci - dd * 72; vst[i] = *(const GAS u32x4*)(vg + (size_t)dd * 8192 + 8 * c); } } }
    const float rp = tid < 465 ? a.in[11][(l * 8 + h) * 465 + tid] : 0.f;
    __syncthreads();
#pragma unroll
    for (int i = 0; i < 9; ++i) { const int ci = tid + 512 * i;
        { const int kk = ci >> 3, ch = ci & 7, col = kk & 63, sw = ((col >> 1) & 1) | (((col >> 3) & 3) << 1); *(LAS u32x4*)(KL + kk * 128 + ((ch ^ sw) << 4)) = kst[i]; }
        { const int dd = ci / 72, c = ci - dd * 72; *(LAS u32x4*)(VL + dd * 1152 + ((c ^ ((dd >> 1) & 7)) << 4)) = vst[i]; } }
    if (tid < 465) rpbh[tid] = rp;
    __syncthreads();
    f32x4 s[16];
    const int kro = 8 * (fr >> 2) + (fr & 3);
#pragma unroll
    for (int t = 0; t < 16; ++t) { const int kr = t >> 1, u2 = t & 1, col = kc0 + kro + 4 * u2, sw = ((col >> 1) & 1) | (((col >> 3) & 3) << 1);
        const LAS unsigned char* kp = KL + ((krw + kr) * 64 + col) * 128; f32x4 acc = (f32x4){0.f, 0.f, 0.f, 0.f};
#pragma unroll
        for (int ks = 0; ks < 2; ++ks) acc = mfma16(*(const LAS bf16x8*)(kp + (((4 * ks + fq) ^ sw) << 4)), qf[ks], acc);
        s[t] = acc; }
    float mx = -INFINITY;
    { const int qcol = 16 * j + fr; const int cs = min(max(qcol - 8, 0), 48);
#pragma unroll
      for (int t = 0; t < 16; ++t) { const int kr = t >> 1, u2 = t & 1, dr = rs + kr - r + 7;
#pragma unroll
          for (int i = 0; i < 4; ++i) { const int kcol = kc0 + 8 * fq + 4 * u2 + i; const bool valid = kcol >= cs && kcol < cs + 16;
              const int dc = min(max(kcol - qcol + 15, 0), 30);
              const float v = valid ? s[t][i] + rpbh[dr * 31 + dc] : -INFINITY;
              s[t][i] = v; mx = fmaxf(mx, v); } } }
    mx = fq_max(mx);
    float sum = 0.f;
#pragma unroll
    for (int t = 0; t < 16; ++t)
#pragma unroll
        for (int i = 0; i < 4; ++i) { const float p = __expf(s[t][i] - mx); s[t][i] = p; sum += p; }
    sum = fq_sum(sum);
    const float inv = 1.0f / sum;
    f32x4 o[4];
#pragma unroll
    for (int nd = 0; nd < 4; ++nd) o[nd] = (f32x4){0.f, 0.f, 0.f, 0.f};
#pragma unroll
    for (int kr = 0; kr < 8; ++kr) { const bf16x8 pa = pk8(s[2 * kr] * inv, s[2 * kr + 1] * inv); const int c = (krw + kr) * 8 + (kc0 >> 3) + fq;
#pragma unroll
        for (int nd = 0; nd < 4; ++nd) o[nd] = mfma16(pa, *(const LAS bf16x8*)(VL + (16 * nd + fr) * 1152 + ((c ^ ((fr >> 1) & 7)) << 4)), o[nd]); }
    float ro[4];
#pragma unroll
    for (int i = 0; i < 4; ++i) { float q2 = 0.f;
#pragma unroll
        for (int nd = 0; nd < 4; ++nd) q2 += o[nd][i] * o[nd][i];
        q2 = fr_sum(q2); ro[i] = rsqrtf(q2 * (1.0f / 64.0f) + EPS); }
    const float* ogain = a.in[12] + l * 512 + 64 * h; GAS bf16_t* y0 = (GAS bf16_t*)(a.ws + WS_Y) + (size_t)tq0 * DM + 1024 + 64 * h;
#pragma unroll
    for (int nd = 0; nd < 4; ++nd) { const float g = ogain[16 * nd + fr];
#pragma unroll
        for (int i = 0; i < 4; ++i) y0[(size_t)(4 * fq + i) * DM + 16 * nd + fr] = f2bf(o[nd][i] * ro[i] * g); }
}

__device__ __forceinline__ void mem_attn_block(const Args& a, LAS unsigned char* lds, int l, int u) {
    const int tid = tidx(), lane = tid & 63, wave = tid >> 6, fr = lane & 15, fq = lane >> 4;
    const int b = u >> 8, h = (u >> 6) & 3, qblk = u & 63, tq0 = b * SEQ + qblk * 128 + 16 * wave;
    const size_t hb = (size_t)((l * 2 + b) * 4 + h) * 32768;
    const GAS u32x4* kg = (const GAS u32x4*)((const GAS bf16_t*)(a.ws + WS_KM) + hb); const GAS u32x4* vg = (const GAS u32x4*)((const GAS bf16_t*)(a.ws + WS_VMT) + hb);
    LAS unsigned char* KL = lds; LAS unsigned char* VL = lds + 65536;
    const GAS bf16_t* qrow = (const GAS bf16_t*)(a.ws + WS_P) + (size_t)(tq0 + fr) * INP + C_MQ + 128 * h;
    bf16x8 qf[4];
#pragma unroll
    for (int ks = 0; ks < 4; ++ks) qf[ks] = *(const GAS bf16x8*)(qrow + 32 * ks + 8 * fq);
    u32x4 kst[8], vst[8];
#pragma unroll
    for (int i = 0; i < 8; ++i) { kst[i] = kg[tid + 512 * i]; vst[i] = vg[tid + 512 * i]; }
    __syncthreads();
#pragma unroll
    for (int i = 0; i < 8; ++i) { const int ci = tid + 512 * i;
        { const int key = ci >> 4, c = ci & 15, sw = (key & 3) | (((key >> 3) & 3) << 2); *(LAS u32x4*)(KL + key * 256 + ((c ^ sw) << 4)) = kst[i]; }
        { const int dd = ci >> 5, c = ci & 31; *(LAS u32x4*)(VL + dd * 512 + ((c ^ (dd & 15)) << 4)) = vst[i]; } }
    float ss = 0.f;
#pragma unroll
    for (int ks = 0; ks < 4; ++ks) { const u32x4 w = __builtin_bit_cast(u32x4, qf[ks]);
#pragma unroll
        for (int e = 0; e < 4; ++e) { const float lo = bflo(w[e]), hi = bfhi(w[e]); ss += lo * lo + hi * hi; } }
    ss = fq_sum(ss);
    const float qscale = rsqrtf(ss * (1.0f / 128.0f) + EPS);
    __syncthreads();
    f32x4 s[16];
    const int kro = 8 * (fr >> 2) + (fr & 3);
#pragma unroll
    for (int t = 0; t < 16; ++t) { const int R = 32 * (t >> 1) + kro + 4 * (t & 1), sw = (R & 3) | (((R >> 3) & 3) << 2);
        const LAS unsigned char* kp = KL + R * 256; f32x4 acc = (f32x4){0.f, 0.f, 0.f, 0.f};
#pragma unroll
        for (int ks = 0; ks < 4; ++ks) acc = mfma16(*(const LAS bf16x8*)(kp + (((4 * ks + fq) ^ sw) << 4)), qf[ks], acc);
        s[t] = acc; }
    float mx = -INFINITY;
#pragma unroll
    for (int t = 0; t < 16; ++t)
#pragma unroll
        for (int i = 0; i < 4; ++i) { const float v = s[t][i] * qscale; s[t][i] = v; mx = fmaxf(mx, v); }
    mx = fq_max(mx);
    float sum = 0.f;
#pragma unroll
    for (int t = 0; t < 16; ++t)
#pragma unroll
        for (int i = 0; i < 4; ++i) { const float p = __expf(s[t][i] - mx); s[t][i] = p; sum += p; }
    sum = fq_sum(sum);
    const float inv = 1.0f / sum;
    f32x4 o[8];
#pragma unroll
    for (int nd = 0; nd < 8; ++nd) o[nd] = (f32x4){0.f, 0.f, 0.f, 0.f};
#pragma unroll
    for (int kr = 0; kr < 8; ++kr) { const bf16x8 pa = pk8(s[2 * kr] * inv, s[2 * kr + 1] * inv);
#pragma unroll
        for (int nd = 0; nd < 8; ++nd) o[nd] = mfma16(pa, *(const LAS bf16x8*)(VL + (16 * nd + fr) * 512 + (((4 * kr + fq) ^ fr) << 4)), o[nd]); }
    float ro[4];
#pragma unroll
    for (int i = 0; i < 4; ++i) { float q2 = 0.f;
#pragma unroll
        for (int nd = 0; nd < 8; ++nd) q2 += o[nd][i] * o[nd][i];
        q2 = fr_sum(q2); ro[i] = rsqrtf(q2 * (1.0f / 128.0f) + EPS); }
    const float* ogain = a.in[17] + l * 512 + 128 * h; GAS bf16_t* y0 = (GAS bf16_t*)(a.ws + WS_Y) + (size_t)tq0 * DM + 1536 + 128 * h;
#pragma unroll
    for (int nd = 0; nd < 8; ++nd) { const float g = ogain[16 * nd + fr];
#pragma unroll
        for (int i = 0; i < 4; ++i) y0[(size_t)(4 * fq + i) * DM + 16 * nd + fr] = f2bf(o[nd][i] * ro[i] * g); }
}

__device__ __forceinline__ void gate_gemm(const Args& a, int l, int G) {
    const int tid = tidx(), lane = tid & 63, wave = tid >> 6, fr = lane & 15, fq = lane >> 4, mt = wave & 3, ct = wave >> 2;
    const GAS bf16_t* XB = (const GAS bf16_t*)(a.ws + WS_XB); const GAS bf16_t* Wg = (const GAS bf16_t*)(a.ws + WS_WIN + l * SZ_WIN) + (size_t)(5120 + 16 * ct + fr) * DM + 8 * fq;
    const GAS float* SSQ = (const GAS float*)(a.ws + WS_SSQ); GAS bf16_t* P = (GAS bf16_t*)(a.ws + WS_P);
    for (int it = blockIdx.x; it < MTOK / 64; it += G) {
        const int r0 = it * 64 + 16 * mt;
        const GAS bf16_t* ap = XB + (size_t)(r0 + fr) * DM + 8 * fq;
        f32x4 acc = (f32x4){0.f, 0.f, 0.f, 0.f};
#pragma unroll 1
        for (int k0 = 0; k0 < 64; k0 += 16) {
            bf16x8 af[16], bfr[16];
#pragma unroll
            for (int j = 0; j < 16; ++j) { af[j] = *(const GAS bf16x8*)(ap + 32 * (k0 + j)); bfr[j] = *(const GAS bf16x8*)(Wg + 32 * (k0 + j)); }
#pragma unroll
            for (int j = 0; j < 16; ++j) acc = mfma16(af[j], bfr[j], acc);
        }
#pragma unroll
        for (int i = 0; i < 4; ++i) { const int row = r0 + 4 * fq + i; const GAS f32x4* sp = (const GAS f32x4*)(SSQ + (size_t)row * 32); float sacc = 0.f;
#pragma unroll
            for (int q = 0; q < 8; ++q) { const f32x4 v = sp[q]; sacc += (v[0] + v[1]) + (v[2] + v[3]); }
            const float r = rsqrtf(sacc * (1.0f / DM) + EPS);
            P[(size_t)row * INP + C_GG + 16 * ct + fr] = f2bf(acc[i] * r); }
    }
}

__global__ void __launch_bounds__(NTHR, 2) fwd_kernel(Args a) {
    extern __shared__ __attribute__((aligned(16))) unsigned char lds_raw[];
    LAS unsigned char* lds = (LAS unsigned char*)lds_raw;
    cg::grid_group grid = cg::this_grid();
    const int G = gridDim.x;
    if (tidx() < 4) ((LAS unsigned*)(lds + LDS_XB))[tidx()] = 0u;
    __syncthreads();
    XcdBarrier xbar; xbar.bar = (unsigned*)a.ws; xbar.x = 0u; xbar.st = (volatile LAS unsigned*)(lds + LDS_XB);
    for (int ph = a.ph_lo; ph < a.ph_hi; ++ph) {
        unsigned char* ws = a.ws; asm volatile("" : "+s"(ws));
        bf16_t* P = (bf16_t*)(ws + WS_P); bf16_t* XB = (bf16_t*)(ws + WS_XB); float* SSQ = (float*)(ws + WS_SSQ); bf16_t* Y = (bf16_t*)(ws + WS_Y); bf16_t* Hb = (bf16_t*)(ws + WS_H);
        bf16_t* NVT = (bf16_t*)(ws + WS_NVT);
        if (ph == 0) { if (blockIdx.x == 0) for (int i = tidx(); i < XCD_BAR_WORDS; i += NTHR) ((GAS unsigned*)a.ws)[i] = 0u;
                       p0_prologue(a, lds, G); }
        else {
            const int l = (ph - 1) / 7, sub = (ph - 1) % 7;
            if (sub == 0) { if (PHM & 2) {
                if (l == 0) {
                    pg8::Gemm g{(const bf16_t*)(ws + WS_MEMN), (const bf16_t*)(ws + WS_WMEM), 512, 4096, DM}; pg8::StaticOrder S; S.init(512, 4096, G, (int)blockIdx.x);
                    EpiPlain E{(bf16_t*)(ws + WS_MKV), 4096};
                    pg8::gemm_phase<EpiPlain, pg8::StaticOrder, true, true>(lds, g, S, E);
                }
                pg8::Gemm g{XB, (const bf16_t*)(ws + WS_WIN + l * SZ_WIN), MTOK, 5120, DM}; pg8::StaticOrder S; S.init(MTOK, 5120, G, (int)blockIdx.x);
                EpiIn E{P, NVT, SSQ, a.in[9] + l * 64, a.in[10] + l * 64};
                pg8::gemm_phase<EpiIn, pg8::StaticOrder, true, true>(lds, g, S, E);
                gate_gemm(a, l, G); }
            } else if (sub == 1) { if (PHM & 4) {
                if (l == 0) memprep(a, G);
                if (blockIdx.x & 1) { for (int u = blockIdx.x; u < 1024; u += G) na_attn_block(a, lds, l, u); __syncthreads(); for (int u = blockIdx.x; u < 2048; u += G) gla_a_unit(a, lds, l, u); }
                else { for (int u = blockIdx.x; u < 2048; u += G) gla_a_unit(a, lds, l, u); __syncthreads(); for (int u = blockIdx.x; u < 1024; u += G) na_attn_block(a, lds, l, u); }
                }
            } else if (sub == 2) { if (PHM & 8) {
                if (blockIdx.x & 1) { for (int u = blockIdx.x; u < 512; u += G) mem_attn_block(a, lds, l, u); gla_scan(a, G); }
                else { gla_scan(a, G); for (int u = blockIdx.x; u < 512; u += G) mem_attn_block(a, lds, l, u); }
                }
            } else if (sub == 3) {
                if (PHM & 16) for (int u = blockIdx.x; u < 2048; u += G) gla_c_unit(a, lds, l, u);
            } else if (sub == 4) { if (PHM & 32) {
                pg8::Gemm g{Y, (const bf16_t*)(ws + WS_WOUT + l * SZ_WOUT), MTOK, DM, DM}; pg8::StaticOrder S; S.init(MTOK, DM, G, (int)blockIdx.x);
                EpiRes E{l == 0 ? a.in[0] : a.out, a.out, XB, SSQ};
                pg8::gemm_phase<EpiRes, pg8::StaticOrder, true, true>(lds, g, S, E); }
            } else if (sub == 5) { if (PHM & 64) {
                pg8::Gemm g{XB, (const bf16_t*)(ws + WS_W13 + l * SZ_W13), MTOK, 2 * DFF, DM}; pg8::StaticOrder S; S.init(MTOK, 2 * DFF, G, (int)blockIdx.x);
                EpiSwiglu E{Hb, SSQ};
                pg8::gemm_phase<EpiSwiglu, pg8::StaticOrder, true, true>(lds, g, S, E); }
            } else { if (PHM & 128) {
                pg8::Gemm g{Hb, (const bf16_t*)(ws + WS_W2 + l * SZ_W2), MTOK, DM, DFF}; pg8::StaticOrder S; S.init(MTOK, DM, G, (int)blockIdx.x);
                EpiRes E{a.out, a.out, XB, SSQ};
                pg8::gemm_phase<EpiRes, pg8::StaticOrder, true, true>(lds, g, S, E); }
            }
        }
        if (ph + 1 < a.ph_hi) {
            if (ph == a.ph_lo) { asm volatile("s_waitcnt vmcnt(0)" ::: "memory"); grid.sync(); __builtin_amdgcn_fence(__ATOMIC_ACQUIRE, "agent"); asm volatile("s_waitcnt vmcnt(0)" ::: "memory");
                                 xbar = xcd_barrier_post((unsigned*)a.ws, (volatile LAS unsigned*)(lds + LDS_XB)); }
            else xcd_barrier(xbar); }
    }
}

#ifndef MK_MULTI_X
#define MK_MULTI 0
#endif
extern "C" void kernel_launch(void* const* d_in, const int* in_sizes, int n_in, void* d_out, int out_size, void* d_ws, size_t ws_size, hipStream_t stream) {
    static int grid = 0;
    if (grid == 0) {
        int dev = 0, cus = 0, per_cu = 0;
        if (n_in != 22 || out_size != MTOK * DM || ws_size < WS_END) { fprintf(stderr, "kernel_launch: unexpected shapes (n_in %d out %d ws %zu need %zu)\n", n_in, out_size, ws_size, (size_t)WS_END); grid = -1; return; }
        (void)hipGetDevice(&dev);
        (void)hipDeviceGetAttribute(&cus, hipDeviceAttributeMultiprocessorCount, dev);
        (void)hipFuncSetAttribute((const void*)fwd_kernel, hipFuncAttributeMaxDynamicSharedMemorySize, LDS_BYTES);
        (void)hipOccupancyMaxActiveBlocksPerMultiprocessor(&per_cu, (const void*)fwd_kernel, NTHR, LDS_BYTES);
        if (per_cu < 1) per_cu = 1;
        grid = cus * per_cu;
        fprintf(stderr, "kernel_launch: grid %d (cus %d x %d), ws %zu\n", grid, cus, per_cu, ws_size);
    }
    if (grid < 0) return;
    Args a{};
    for (int i = 0; i < 22; ++i) a.in[i] = (const float*)d_in[i];
    a.out = (float*)d_out; a.ws = (unsigned char*)d_ws;
    constexpr int NPH = 1 + 7 * DEPTH;
#if MK_MULTI
    for (int ph = 0; ph < NPH; ++ph) { a.ph_lo = ph; a.ph_hi = ph + 1; hipLaunchKernelGGL(fwd_kernel, dim3(grid), dim3(NTHR), LDS_BYTES, stream, a); }
#else
    a.ph_lo = 0; a.ph_hi = NPH;
    void* args[] = {&a};
    hipError_t e = hipLaunchCooperativeKernel((const void*)fwd_kernel, dim3(grid), dim3(NTHR), args, LDS_BYTES, stream);
    if (e != hipSuccess) fprintf(stderr, "kernel_launch: cooperative launch failed: %s (grid %d)\n", hipGetErrorString(e), grid);
#endif
}
```

```cpp
#include <hip/hip_runtime.h>
#include <hip/hip_cooperative_groups.h>
#include <cstdio>
#include <cstdint>
namespace cg = cooperative_groups;
__device__ __forceinline__ int tidx() { int t = threadIdx.x; asm volatile("" : "+v"(t)); return t; }
namespace pg8 {
#define PG8_LAS __attribute__((address_space(3)))
typedef unsigned short bf16_t;
typedef short bf16x8 __attribute__((ext_vector_type(8)));
typedef float f32x4 __attribute__((ext_vector_type(4)));
typedef unsigned u32x4 __attribute__((ext_vector_type(4)));
constexpr int BM = 256, BK = 64, HALF = 128, HTB = HALF * BK * 2  , STAGE_BYTES = 8 * HTB, NXCD = 8, WGM = 8;

__host__ __device__ __forceinline__ int lds_byte(int r, int c) { const int st = (r >> 4) * 2 + (c >> 5), rr = r & 15, cc = c & 31, ob = rr * 64 + cc * 2; return st * 1024 + (ob ^ (((ob >> 9) & 1) << 5)); }
__host__ __device__ __forceinline__ void stage_rc(int b, int& R, int& C) { const int st = b / 1024, sb = b % 1024, swz = sb ^ (((sb >> 9) & 1) << 5); R = (st >> 1) * 16 + swz / 64; C = (st & 1) * 32 + (swz % 64) / 2; }
__host__ __device__ __forceinline__ int perm32(int rho) { const int n = rho >> 4, i = rho & 15; return 8 * (i >> 2) + 4 * n + (i & 3); }

struct Unit { int pm, pn; };
struct Gemm { const bf16_t* A; const bf16_t* Bt; int M, N, K; };

struct StaticOrder {
    int nM, nN, nwg, G, c;
    __host__ __device__ void init(int M, int N, int G_, int c_) { nM = M / BM; nN = N / BM; nwg = nM * nN; G = G_; c = c_; }
    __host__ __device__ bool next(int i, Unit& u) const {
        const long L = (long)i * G + c; if (L >= nwg) return false;
        int wgid = (int)L; { const int q = nwg / NXCD, r = nwg % NXCD, xcd = wgid % NXCD, off = wgid / NXCD; wgid = (xcd < r ? xcd * (q + 1) : r * (q + 1) + (xcd - r) * q) + off; }
        const int nig = WGM * nN, gid = wgid / nig, fm = gid * WGM, gsz = (nM - fm) < WGM ? (nM - fm) : WGM;
        u.pm = fm + ((wgid % nig) % gsz); u.pn = (wgid % nig) / gsz; return true;
    }
    __device__ __forceinline__ void a_ready(const Unit&) const {}
    __device__ __forceinline__ void done(const Unit&) const {}
};

typedef float f32x2_t __attribute__((ext_vector_type(2))); typedef __bf16 bf16x2_t __attribute__((ext_vector_type(2)));
__device__ __forceinline__ unsigned cvt_pk_bf16(float lo, float hi) { f32x2_t v = {lo, hi}; bf16x2_t b = __builtin_convertvector(v, bf16x2_t); return __builtin_bit_cast(unsigned, b); }
template <class Epi, class Sched, bool ALIGN_EPI = false, bool SP2 = false>
__device__ __forceinline__ void gemm_phase(PG8_LAS unsigned char* lds, const Gemm g, const Sched& S, const Epi& E) {
    const int tid = tidx(), wid = __builtin_amdgcn_readfirstlane(tid >> 6), lane = tid & 63, wr = wid >> 2, wc = wid & 3, fr = lane & 15, fq = lane >> 4;
    const int K = g.K, nt = K / BK;
    unsigned voffA[2], voffB[2];
#pragma unroll
    for (int i = 0; i < 2; ++i) { int R, C; stage_rc(tid * 16 + i * 8192, R, C); const int Rb = Epi::PERM ? ((R & ~31) + perm32(R & 31)) : R;
        voffA[i] = (unsigned)(R * K + C) * 2u; voffB[i] = (unsigned)(Rb * K + C) * 2u; }
    const size_t kstep = (size_t)(BK * 2);
    const size_t hstep = (size_t)HALF * K * 2;
    const size_t tstep = 2 * hstep;
    const unsigned ldsw = (unsigned)wid * 1024u;
    const int aoff = lds_byte(wr * 64 + fr, fq * 8), boff = lds_byte(wc * 32 + fr, fq * 8);
#define PG8_SA(b, h) (((b) * 2 + (h)) * HTB)
#define PG8_SB(b, h) ((4 + (b) * 2 + (h)) * HTB)
#define PG8_STAGE(bufoff, gbase, voff) do { _Pragma("unroll") for (int _i = 0; _i < 2; ++_i) \
        __builtin_amdgcn_global_load_lds((const unsigned*)((const char*)(gbase) + (voff)[_i]), (PG8_LAS unsigned*)(lds + (bufoff) + ldsw + _i * 8192), 16, 0, 0); } while (0)
#define PG8_LDA(dst, b, h) do { _Pragma("unroll") for (int m = 0; m < 4; ++m) _Pragma("unroll") for (int k = 0; k < 2; ++k) dst[m][k] = *(const PG8_LAS bf16x8*)(lds + PG8_SA(b, h) + aoff + m * 2048 + k * 1024); } while (0)
#define PG8_LDB(dst, b, h) do { _Pragma("unroll") for (int n = 0; n < 2; ++n) _Pragma("unroll") for (int k = 0; k < 2; ++k) dst[n][k] = *(const PG8_LAS bf16x8*)(lds + PG8_SB(b, h) + boff + n * 2048 + k * 1024); } while (0)
#define PG8_MMA(ai, bj, At, Bt) do { __builtin_amdgcn_s_setprio(1); _Pragma("unroll") for (int m = 0; m < 4; ++m) _Pragma("unroll") for (int n = 0; n < 2; ++n) _Pragma("unroll") for (int k = 0; k < 2; ++k) \
        acc[ai][bj][m][n] = __builtin_amdgcn_mfma_f32_16x16x32_bf16(Bt[n][k], At[m][k], acc[ai][bj][m][n], 0, 0, 0); __builtin_amdgcn_s_setprio(0); } while (0)
#define PG8_WAIT_V(n) asm volatile("s_waitcnt vmcnt(" #n ")" ::: "memory")
#define PG8_WAIT_L(n) asm volatile("s_waitcnt lgkmcnt(" #n ")" ::: "memory")
#define PG8_BAR __builtin_amdgcn_s_barrier()
#define PG8_SCHED __builtin_amdgcn_sched_barrier(0)
    Unit cur, nxt; int ui = 0;
    if (!S.next(0, cur)) return;
    f32x4 acc[2][2][4][2];
#pragma unroll
    for (int a = 0; a < 2; ++a)
#pragma unroll
        for (int b = 0; b < 2; ++b)
#pragma unroll
            for (int m = 0; m < 4; ++m)
#pragma unroll
                for (int n = 0; n < 2; ++n) acc[a][b][m][n] = (f32x4){0.f, 0.f, 0.f, 0.f};
    bf16x8 At[4][2], B0[2][2], B1[2][2];
    const char* cA = (const char*)g.A + (size_t)cur.pm * tstep; const char* cB = (const char*)g.Bt + (size_t)cur.pn * tstep;
    S.a_ready(cur);
    if constexpr (SP2) {
        PG8_STAGE(PG8_SB(0, 0), cB, voffB); PG8_STAGE(PG8_SB(0, 1), cB + hstep, voffB); PG8_STAGE(PG8_SA(0, 0), cA, voffA); PG8_STAGE(PG8_SA(0, 1), cA + hstep, voffA);
        if (wr == 1) PG8_BAR;
        PG8_WAIT_V(2); PG8_BAR;
        PG8_STAGE(PG8_SB(1, 0), cB + kstep, voffB); PG8_STAGE(PG8_SA(1, 0), cA + kstep, voffA); PG8_STAGE(PG8_SB(1, 1), cB + hstep + kstep, voffB);
        PG8_WAIT_V(6); PG8_BAR;
    } else {
        PG8_STAGE(PG8_SB(0, 0), cB, voffB); PG8_STAGE(PG8_SA(0, 0), cA, voffA); PG8_STAGE(PG8_SB(0, 1), cB + hstep, voffB); PG8_STAGE(PG8_SA(0, 1), cA + hstep, voffA);
        if (wr == 1) PG8_BAR;
        PG8_WAIT_V(4); PG8_BAR;
        PG8_STAGE(PG8_SB(1, 0), cB + kstep, voffB); PG8_STAGE(PG8_SA(1, 0), cA + kstep, voffA); PG8_STAGE(PG8_SB(1, 1), cB + hstep + kstep, voffB);
        PG8_WAIT_V(6); PG8_BAR;
    }
    for (;;) {
        const bool has_next = S.next(ui + 1, nxt);
        const char* nA = has_next ? (const char*)g.A + (size_t)nxt.pm * tstep : cA; const char* nB = has_next ? (const char*)g.Bt + (size_t)nxt.pn * tstep : cB;
        for (int t = 0; t < nt; t += 2) {
            const bool last = (t == nt - 2);
            const char* a1 = cA + (size_t)(t + 1) * kstep;
            const char* a2 = last ? nA : cA + (size_t)(t + 2) * kstep; const char* b2 = last ? nB : cB + (size_t)(t + 2) * kstep;
            const char* a3 = a2 + kstep; const char* b3 = b2 + kstep;
            if (last && has_next) S.a_ready(nxt);
            if constexpr (SP2) {
            PG8_LDB(B0, 0, 0); PG8_LDB(B1, 0, 1); PG8_SCHED; PG8_LDA(At, 0, 0); PG8_STAGE(PG8_SA(1, 1), a1 + hstep, voffA);
            PG8_WAIT_V(8); PG8_WAIT_L(0); PG8_BAR; PG8_MMA(0, 0, At, B0); PG8_MMA(0, 1, At, B1); PG8_BAR; PG8_SCHED;
            PG8_LDA(At, 0, 1); PG8_STAGE(PG8_SB(0, 0), b2, voffB); PG8_STAGE(PG8_SB(0, 1), b2 + hstep, voffB); PG8_STAGE(PG8_SA(0, 0), a2, voffA);
            PG8_WAIT_V(8); PG8_WAIT_L(0); PG8_BAR; PG8_MMA(1, 0, At, B0); PG8_MMA(1, 1, At, B1); PG8_BAR; PG8_SCHED;
            PG8_LDB(B0, 1, 0); PG8_LDB(B1, 1, 1); PG8_SCHED; PG8_LDA(At, 1, 0); PG8_STAGE(PG8_SA(0, 1), a2 + hstep, voffA);
            PG8_WAIT_V(8); PG8_WAIT_L(0); PG8_BAR; PG8_MMA(0, 0, At, B0); PG8_MMA(0, 1, At, B1); PG8_BAR; PG8_SCHED;
            PG8_LDA(At, 1, 1); PG8_STAGE(PG8_SB(1, 0), b3, voffB); PG8_STAGE(PG8_SB(1, 1), b3 + hstep, voffB); PG8_STAGE(PG8_SA(1, 0), a3, voffA);
            PG8_WAIT_V(8); PG8_WAIT_L(0); PG8_BAR; PG8_MMA(1, 0, At, B0); PG8_MMA(1, 1, At, B1); PG8_BAR; PG8_SCHED;
            } else {
            PG8_LDB(B0, 0, 0); PG8_SCHED; PG8_LDA(At, 0, 0); PG8_STAGE(PG8_SA(1, 1), a1 + hstep, voffA);
            PG8_WAIT_L(8); PG8_BAR; PG8_WAIT_L(0); PG8_MMA(0, 0, At, B0); PG8_BAR; PG8_SCHED;
            PG8_LDB(B1, 0, 1); PG8_STAGE(PG8_SB(0, 0), b2, voffB);
            PG8_BAR; PG8_WAIT_L(0); PG8_MMA(0, 1, At, B1); PG8_BAR;
            PG8_LDA(At, 0, 1); PG8_STAGE(PG8_SA(0, 0), a2, voffA);
            PG8_BAR; PG8_WAIT_L(0); PG8_MMA(1, 0, At, B0); PG8_BAR; PG8_SCHED;
            PG8_STAGE(PG8_SB(0, 1), b2 + hstep, voffB);
            PG8_WAIT_V(6); PG8_BAR; PG8_MMA(1, 1, At, B1); PG8_BAR;
            PG8_LDB(B0, 1, 0); PG8_SCHED; PG8_LDA(At, 1, 0); PG8_STAGE(PG8_SA(0, 1), a2 + hstep, voffA);
            PG8_WAIT_L(8); PG8_BAR; PG8_WAIT_L(0); PG8_MMA(0, 0, At, B0); PG8_BAR; PG8_SCHED;
            PG8_LDB(B1, 1, 1); PG8_STAGE(PG8_SB(1, 0), b3, voffB);
            PG8_BAR; PG8_WAIT_L(0); PG8_MMA(0, 1, At, B1); PG8_BAR;
            PG8_LDA(At, 1, 1); PG8_STAGE(PG8_SA(1, 0), a3, voffA);
            PG8_BAR; PG8_WAIT_L(0); PG8_MMA(1, 0, At, B0); PG8_BAR; PG8_SCHED;
            PG8_STAGE(PG8_SB(1, 1), b3 + hstep, voffB);
            PG8_WAIT_V(6); PG8_BAR; PG8_MMA(1, 1, At, B1); PG8_BAR;
            }
        }
        if constexpr (ALIGN_EPI) { if (wr == 0) PG8_BAR; }
        if constexpr (!Epi::AFTER_DRAIN) { E(acc, cur, wr, wc, fr, fq); S.done(cur); }
        if (!has_next) break;
#pragma unroll
        for (int a = 0; a < 2; ++a)
#pragma unroll
            for (int b = 0; b < 2; ++b)
#pragma unroll
                for (int m = 0; m < 4; ++m)
#pragma unroll
                    for (int n = 0; n < 2; ++n) acc[a][b][m][n] = (f32x4){0.f, 0.f, 0.f, 0.f};
        cur = nxt; cA = nA; cB = nB; ++ui;
        if constexpr (ALIGN_EPI) { if (wr == 1) PG8_BAR; }
    }
    PG8_WAIT_V(0);
    if constexpr (!ALIGN_EPI) { if (wr == 0) PG8_BAR; }
    PG8_BAR;
    if constexpr (Epi::AFTER_DRAIN) { E.fused(acc, cur, wr, wc, fr, fq, lds, wid, lane); S.done(cur); }
#undef PG8_SA
#undef PG8_SB
#undef PG8_STAGE
#undef PG8_LDA
#undef PG8_LDB
#undef PG8_MMA
#undef PG8_WAIT_V
#undef PG8_WAIT_L
#undef PG8_BAR
#undef PG8_SCHED
}
}

#define LAS __attribute__((address_space(3)))
#define GAS __attribute__((address_space(1)))
#define XB_TMO      128
#define XB_XCNT(j)  (256  + 64 * (j))
#define XB_XSUB(j)  (1280 + 64 * (j))
#define XB_XGEN(j)  (2304 + 64 * (j))
#define XB_TOP      3328
#define XB_TOPGEN   3392
#define XCD_BAR_WORDS 3456
#define XB_SPIN_CAP (1u << 18)

__device__ __forceinline__ unsigned xb_ld(unsigned* p)              { return __hip_atomic_load(p, __ATOMIC_RELAXED, __HIP_MEMORY_SCOPE_AGENT); }
__device__ __forceinline__ unsigned xb_add(unsigned* p, unsigned v) { return __hip_atomic_fetch_add(p, v, __ATOMIC_RELAXED, __HIP_MEMORY_SCOPE_AGENT); }
__device__ __forceinline__ unsigned xb_xcc_id() { return (unsigned)__builtin_amdgcn_s_getreg((3 << 11) | 20) & 0xFu; }
#define XB_SPIN(cond, bar) do { unsigned _sp = 0; while (cond) { __builtin_amdgcn_s_sleep(1); \
    if ((++_sp & 255u) == 0u) { if (xb_ld(&(bar)[XB_TMO])) break; if (_sp > XB_SPIN_CAP) { atomicAdd(&(bar)[XB_TMO], 1u); break; } } } } while (0)

struct XcdBarrier {
    unsigned* bar; unsigned x;
    volatile LAS unsigned* st;
};

__device__ __forceinline__ XcdBarrier xcd_barrier_post(unsigned* bar, volatile LAS unsigned* st) {
    XcdBarrier b; b.bar = bar; b.x = xb_xcc_id(); b.st = st;
    if (threadIdx.x == 0) (void)xb_add(&bar[XB_XCNT(b.x)], 1u);
    return b;
}
__device__ __forceinline__ void xcd_barrier_complete(unsigned* bar, unsigned x, unsigned& nloc, unsigned& nx) {
    const unsigned G = gridDim.x * gridDim.y * gridDim.z;
    unsigned sum, cnt, mine, sp = 0u;
    for (;;) {
        sum = 0u; cnt = 0u; mine = 0u;
#pragma unroll
        for (unsigned j = 0; j < 16; ++j) { const unsigned c = xb_ld(&bar[XB_XCNT(j)]); sum += c; cnt += (c > 0u) ? 1u : 0u; mine = (j == x) ? c : mine; }
        if (sum == G) break;
        __builtin_amdgcn_s_sleep(1);
        if ((++sp & 255u) == 0u) { if (xb_ld(&bar[XB_TMO])) break; if (sp > XB_SPIN_CAP) { atomicAdd(&bar[XB_TMO], 1u); break; } }
    }
    nloc = mine > 0u ? mine : 1u; nx = cnt > 0u ? cnt : 1u;
}

__device__ __forceinline__ void xcd_barrier(const XcdBarrier& b) {
    asm volatile("s_waitcnt vmcnt(0)" ::: "memory");
    __syncthreads();
    if (threadIdx.x == 0) {
        unsigned* bar = b.bar;
        __builtin_amdgcn_s_waitcnt(0);
        unsigned nloc = b.st[0], nx = b.st[1];
        if (nloc == 0u) { xcd_barrier_complete(bar, b.x, nloc, nx); b.st[0] = nloc; b.st[1] = nx; }
        const unsigned old = xb_add(&bar[XB_XSUB(b.x)], 1u);
        const unsigned gen = old / nloc;
        if (old + 1u == (gen + 1u) * nloc) {
            __builtin_amdgcn_fence(__ATOMIC_RELEASE, "agent");
            asm volatile("s_waitcnt vmcnt(0)" ::: "memory");
            const unsigned og = xb_add(&bar[XB_TOP], 1u);
            const unsigned tg = og / nx;
            if (og + 1u == (tg + 1u) * nx) xb_add(&bar[XB_TOPGEN], 1u);
            else XB_SPIN(xb_ld(&bar[XB_TOPGEN]) == tg, bar);
            __builtin_amdgcn_fence(__ATOMIC_ACQUIRE, "agent");
            xb_add(&bar[XB_XGEN(b.x)], 1u);
            asm volatile("s_waitcnt vmcnt(0)" ::: "memory");
        } else {
            XB_SPIN(xb_ld(&bar[XB_XGEN(b.x)]) == gen, bar);
            __builtin_amdgcn_fence(__ATOMIC_ACQUIRE, "agent");
            asm volatile("s_waitcnt vmcnt(0)" ::: "memory");
        }
    }
    __syncthreads();
}

using pg8::bf16_t; using pg8::bf16x8; using pg8::f32x4; using pg8::Unit; using pg8::cvt_pk_bf16;
typedef unsigned u32x2 __attribute__((ext_vector_type(2)));
typedef unsigned u32x4 __attribute__((ext_vector_type(4)));
typedef float f32x2 __attribute__((ext_vector_type(2)));

constexpr int DM = 2048, BATCH = 2, SEQ = 8192, DEPTH = 4, MTOK = BATCH * SEQ;
constexpr int INC = 5152, INP = 5376, DFF = 5632, MEMT = 256;
constexpr int C_GQ = 0, C_GK = 512, C_GV = 1024, C_GR = 2048, C_NQ = 3072, C_NK = 3584, C_NV = 4096, C_MQ = 4608, C_GG = 5120;
constexpr float EPS = 1e-6f;
constexpr int NTHR = 512, NWAVES = 8;

constexpr size_t MiB = 1u << 20;
constexpr size_t WS_WG2T = 65536;
constexpr size_t WS_WIN = 1 * MiB, SZ_WIN = (size_t)INP * DM * 2;
constexpr size_t WS_WOUT = WS_WIN + 4 * SZ_WIN, SZ_WOUT = (size_t)DM * DM * 2;
constexpr size_t WS_W13 = WS_WOUT + 4 * SZ_WOUT, SZ_W13 = (size_t)2 * DFF * DM * 2;
constexpr size_t WS_W2 = WS_W13 + 4 * SZ_W13, SZ_W2 = (size_t)DM * DFF * 2;
constexpr size_t WS_WMEM = WS_W2 + 4 * SZ_W2;
constexpr size_t WS_XB = WS_WMEM + (size_t)4096 * DM * 2;
constexpr size_t WS_SSQ = WS_XB + (size_t)MTOK * DM * 2;
constexpr size_t WS_P = WS_SSQ + (size_t)MTOK * 32 * 4;
constexpr size_t WS_NVT = WS_P + (size_t)MTOK * INP * 2;
constexpr size_t WS_Y = WS_NVT + (size_t)MTOK * 512 * 2;
constexpr size_t WS_ST = WS_Y + (size_t)MTOK * DM * 2;
constexpr size_t WS_DEC = WS_ST + (size_t)2048 * 2 * 32768 * 2;
constexpr size_t WS_MEMN = WS_DEC + (size_t)2048 * 2 * 128 * 4;
constexpr size_t WS_MKV = WS_MEMN + (size_t)512 * DM * 2;
constexpr size_t WS_KM = WS_MKV + (size_t)512 * 4096 * 2;
constexpr size_t WS_VMT = WS_KM + (size_t)32 * 256 * 128 * 2;
constexpr size_t WS_H = WS_VMT + (size_t)32 * 256 * 128 * 2;
constexpr size_t WS_ST2 = WS_H;
constexpr size_t WS_CUMG = WS_ST2 + (size_t)2048 * 2 * 32768 * 2;
constexpr size_t WS_END = WS_CUMG + (size_t)2 * MTOK * 512 * 4;

constexpr int LDS_BYTES = 147456 + 4096;
constexpr int LDS_XB = 147456 + 3584;
#ifndef PHM
#define PHM 255
#endif

__device__ __forceinline__ float bflo(unsigned w) { return __uint_as_float(w << 16); }
__device__ __forceinline__ float bfhi(unsigned w) { return __uint_as_float(w & 0xffff0000u); }
__device__ __forceinline__ float bf2f(unsigned short b) { return __uint_as_float((unsigned)b << 16); }
__device__ __forceinline__ unsigned short f2bf(float f) { return (unsigned short)(cvt_pk_bf16(f, 0.f) & 0xffffu); }
__device__ __forceinline__ float wave_sum(float v) {
#pragma unroll
    for (int o = 1; o < 64; o <<= 1) v += __shfl_xor(v, o);
    return v;
}
__device__ __forceinline__ float fq_sum(float v) { v += __shfl_xor(v, 16); v += __shfl_xor(v, 32); return v; }
__device__ __forceinline__ float fq_max(float v) { v = fmaxf(v, __shfl_xor(v, 16)); v = fmaxf(v, __shfl_xor(v, 32)); return v; }
__device__ __forceinline__ float fr_sum(float v) { v += __shfl_xor(v, 1); v += __shfl_xor(v, 2); v += __shfl_xor(v, 4); v += __shfl_xor(v, 8); return v; }
__device__ __forceinline__ float dot4(f32x4 a) { return (a[0] * a[0] + a[1] * a[1]) + (a[2] * a[2] + a[3] * a[3]); }
__device__ __forceinline__ u32x2 pk4(f32x4 v) { u32x2 w; w.x = cvt_pk_bf16(v[0], v[1]); w.y = cvt_pk_bf16(v[2], v[3]); return w; }
__device__ __forceinline__ bf16x8 pk8(f32x4 a, f32x4 b) { u32x4 w; w.x = cvt_pk_bf16(a[0], a[1]); w.y = cvt_pk_bf16(a[2], a[3]); w.z = cvt_pk_bf16(b[0], b[1]); w.w = cvt_pk_bf16(b[2], b[3]); return __builtin_bit_cast(bf16x8, w); }
__device__ __forceinline__ f32x4 mfma16(bf16x8 a, bf16x8 b, f32x4 c) { return __builtin_amdgcn_mfma_f32_16x16x32_bf16(a, b, c, 0, 0, 0); }

__device__ __forceinline__ void row_rstd(const float* ssq, int rowb, int fq, float (&rs)[2][4]) {
#pragma unroll
    for (int ai = 0; ai < 2; ++ai)
#pragma unroll
        for (int m = 0; m < 4; ++m) {
            const f32x4* sp = (const f32x4*)(ssq + (size_t)(rowb + ai * 128 + m * 16) * 32 + fq * 8);
            const f32x4 a = sp[0], b = sp[1];
            float s = ((a[0] + a[1]) + (a[2] + a[3])) + ((b[0] + b[1]) + (b[2] + b[3]));
            s = fq_sum(s);
            rs[ai][m] = rsqrtf(s * (1.0f / DM) + EPS);
        }
}

struct EpiIn {
    static constexpr bool PERM = false, AFTER_DRAIN = false;
    bf16_t* P; bf16_t* NVT; const float* ssq; const float* gq; const float* gk;
    __device__ __forceinline__ void operator()(const f32x4 (&acc)[2][2][4][2], const Unit& u, int wr, int wc, int fr, int fq) const {
        const int rowb = u.pm * 256 + wr * 64 + fr, pn = u.pn;
        float rs[2][4]; row_rstd(ssq, rowb, fq, rs);
        if (pn >= 12 && pn < 16) {
            const float* g = pn < 14 ? gq : gk; const float sc = pn < 14 ? 0.125f : 1.0f;
            f32x4 gv[2][2];
#pragma unroll
            for (int bj = 0; bj < 2; ++bj)
#pragma unroll
                for (int n = 0; n < 2; ++n) gv[bj][n] = *(const f32x4*)(g + 32 * bj + 16 * n + 4 * fq) * sc;
#pragma unroll
            for (int ai = 0; ai < 2; ++ai)
#pragma unroll
                for (int m = 0; m < 4; ++m) {
                    const float r = rs[ai][m]; float q = 0.f; f32x4 v[2][2];
#pragma unroll
                    for (int bj = 0; bj < 2; ++bj)
#pragma unroll
                        for (int n = 0; n < 2; ++n) { v[bj][n] = acc[ai][bj][m][n] * r; q += dot4(v[bj][n]); }
                    q = fq_sum(q);
                    const float hr = rsqrtf(q * (1.0f / 64.0f) + EPS);
                    bf16_t* rowp = P + (size_t)(rowb + ai * 128 + m * 16) * INP + pn * 256 + 64 * wc + 4 * fq;
#pragma unroll
                    for (int bj = 0; bj < 2; ++bj)
#pragma unroll
                        for (int n = 0; n < 2; ++n) *(u32x2*)(rowp + 32 * bj + 16 * n) = pk4(v[bj][n] * hr * gv[bj][n]);
                    asm volatile("" ::: "memory");
                }
        } else if (pn == 16 || pn == 17) {
#pragma unroll
            for (int ai = 0; ai < 2; ++ai)
#pragma unroll
                for (int m = 0; m < 4; ++m) {
                    const int row = rowb + ai * 128 + m * 16, b = row >> 13, tok = row & 8191; const float r = rs[ai][m];
#pragma unroll
                    for (int bj = 0; bj < 2; ++bj)
#pragma unroll
                        for (int n = 0; n < 2; ++n) {
                            const int c = (pn - 16) * 256 + bj * 128 + wc * 32 + n * 16 + 4 * fq;
                            bf16_t* p = NVT + ((size_t)(b * 512 + c)) * 8192 + tok;
                            const f32x4 v = acc[ai][bj][m][n] * r;
                            p[0] = f2bf(v[0]); p[8192] = f2bf(v[1]); p[2 * 8192] = f2bf(v[2]); p[3 * 8192] = f2bf(v[3]);
                            asm volatile("" ::: "memory");
                        }
                }
        } else {
            const float sc = pn < 2 ? 0.08838834764831845f : 1.0f;
#pragma unroll
            for (int ai = 0; ai < 2; ++ai)
#pragma unroll
                for (int m = 0; m < 4; ++m) {
                    const float r = rs[ai][m] * sc;
                    bf16_t* rowp = P + (size_t)(rowb + ai * 128 + m * 16) * INP + pn * 256 + wc * 32 + 4 * fq;
#pragma unroll
                    for (int bj = 0; bj < 2; ++bj)
#pragma unroll
                        for (int n = 0; n < 2; ++n) *(u32x2*)(rowp + bj * 128 + n * 16) = pk4(acc[ai][bj][m][n] * r);
                    asm volatile("" ::: "memory");
                }
        }
    }
};

struct EpiRes {
    static constexpr bool PERM = false, AFTER_DRAIN = false;
    const float* xin; float* xout; bf16_t* XB; float* ssq;
    __device__ __forceinline__ void operator()(const f32x4 (&acc)[2][2][4][2], const Unit& u, int wr, int wc, int fr, int fq) const {
        const int rowb = u.pm * 256 + wr * 64 + fr, colb = u.pn * 256 + wc * 32 + 4 * fq;
#pragma unroll
        for (int ai = 0; ai < 2; ++ai) {
            f32x4 xr[4][2][2];
#pragma unroll
            for (int m = 0; m < 4; ++m)
#pragma unroll
                for (int bj = 0; bj < 2; ++bj)
#pragma unroll
                    for (int n = 0; n < 2; ++n) xr[m][bj][n] = *(const GAS f32x4*)((const GAS float*)xin + (size_t)(rowb + ai * 128 + m * 16) * DM + colb + bj * 128 + n * 16);
#pragma unroll
            for (int m = 0; m < 4; ++m) {
                const int row = rowb + ai * 128 + m * 16; float q = 0.f;
#pragma unroll
                for (int bj = 0; bj < 2; ++bj)
#pragma unroll
                    for (int n = 0; n < 2; ++n) {
                        const size_t off = (size_t)row * DM + colb + bj * 128 + n * 16;
                        const f32x4 x = xr[m][bj][n] + acc[ai][bj][m][n];
                        *(GAS f32x4*)((GAS float*)xout + off) = x; *(GAS u32x2*)((GAS bf16_t*)XB + off) = pk4(x); q += dot4(x);
                    }
                q = fq_sum(q);
                if (fq == 0) ssq[(size_t)row * 32 + u.pn * 4 + wc] = q;
            }
            asm volatile("" ::: "memory");
        }
    }
};

struct EpiSwiglu {
    static constexpr bool PERM = false, AFTER_DRAIN = false;
    bf16_t* H; const float* ssq;
    __device__ __forceinline__ void operator()(const f32x4 (&acc)[2][2][4][2], const Unit& u, int wr, int wc, int fr, int fq) const {
        const int rowb = u.pm * 256 + wr * 64 + fr;
        float rs[2][4]; row_rstd(ssq, rowb, fq, rs);
#pragma unroll
        for (int ai = 0; ai < 2; ++ai)
#pragma unroll
            for (int m = 0; m < 4; ++m) {
                const float r = rs[ai][m];
                bf16_t* rowp = H + (size_t)(rowb + ai * 128 + m * 16) * DFF + u.pn * 128 + wc * 32 + 4 * fq;
#pragma unroll
                for (int n = 0; n < 2; ++n) {
                    const f32x4 g = acc[ai][0][m][n] * r, up = acc[ai][1][m][n] * r; f32x4 h;
#pragma unroll
                    for (int e = 0; e < 4; ++e) h[e] = g[e] * __builtin_amdgcn_rcpf(1.0f + __expf(-g[e])) * up[e];
                    *(u32x2*)(rowp + n * 16) = pk4(h);
                }
            }
    }
};

struct EpiPlain {
    static constexpr bool PERM = false, AFTER_DRAIN = false;
    bf16_t* O; int ldc;
    __device__ __forceinline__ void operator()(const f32x4 (&acc)[2][2][4][2], const Unit& u, int wr, int wc, int fr, int fq) const {
        const int rowb = u.pm * 256 + wr * 64 + fr;
#pragma unroll
        for (int ai = 0; ai < 2; ++ai)
#pragma unroll
            for (int m = 0; m < 4; ++m) {
                bf16_t* rowp = O + (size_t)(rowb + ai * 128 + m * 16) * ldc + u.pn * 256 + wc * 32 + 4 * fq;
#pragma unroll
                for (int bj = 0; bj < 2; ++bj)
#pragma unroll
                    for (int n = 0; n < 2; ++n) *(u32x2*)(rowp + bj * 128 + n * 16) = pk4(acc[ai][bj][m][n]);
            }
    }
};

__device__ __forceinline__ int in_map(int c) {
    if (c < 3072) return c;
    if (c < 4096) { const int cc = c - 3072, t = cc >> 8, cl = cc & 255, bj = cl >> 7, wc = (cl >> 5) & 3; return 3104 + 256 * t + 64 * wc + 32 * bj; }
    if (c < 5120) return c + 32;
    if (c == 5120) return 3072;
    return -1;
}
__device__ __forceinline__ int w13_map(int c) { const int t = c >> 8, cl = c & 255; return cl < 128 ? 128 * t + cl : DFF + 128 * t + (cl - 128); }

__device__ __forceinline__ void tr_item(const float* W, int ldw, int sc, const float* gain, bf16_t* WT, int K, int drow0, int k0, LAS float* scr, int lane) {
    if (sc < 0) {
        const int c = lane & 7;
#pragma unroll
        for (int j = 0; j < 4; ++j) { const int n = (lane >> 3) + 8 * j; *(u32x4*)(WT + (size_t)(drow0 + n) * K + k0 + 8 * c) = (u32x4){0u, 0u, 0u, 0u}; }
        return;
    }
    { const GAS float* wp = (const GAS float*)W + (size_t)(k0 + (lane >> 5)) * ldw + sc + (lane & 31); float w[32];
#pragma unroll
      for (int i = 0; i < 32; ++i) w[i] = wp[(size_t)(2 * i) * ldw];
      if (gain) { const GAS float* gp = (const GAS float*)gain + k0 + (lane >> 5);
#pragma unroll
          for (int i = 0; i < 32; ++i) w[i] *= gp[2 * i]; }
#pragma unroll
      for (int i = 0; i < 32; ++i) scr[(2 * i + (lane >> 5)) * 33 + (lane & 31)] = w[i]; }
    asm volatile("s_waitcnt lgkmcnt(0)" ::: "memory");
    const int c = lane & 7;
#pragma unroll
    for (int j = 0; j < 4; ++j) { const int n = (lane >> 3) + 8 * j; const LAS float* s = scr + (8 * c) * 33 + n;
        u32x4 o; o.x = cvt_pk_bf16(s[0 * 33], s[1 * 33]); o.y = cvt_pk_bf16(s[2 * 33], s[3 * 33]); o.z = cvt_pk_bf16(s[4 * 33], s[5 * 33]); o.w = cvt_pk_bf16(s[6 * 33], s[7 * 33]);
        *(u32x4*)(WT + (size_t)(drow0 + n) * K + k0 + 8 * c) = o; }
    asm volatile("s_waitcnt lgkmcnt(0)" ::: "memory");
}

struct Args { const float* in[22]; float* out; unsigned char* ws; int ph_lo, ph_hi; };

__device__ __forceinline__ void p0_prologue(const Args& a, LAS unsigned char* lds, int G) {
    const int tid = tidx(), lane = tid & 63, wave = tid >> 6;
    LAS float* scr = (LAS float*)(lds + wave * 16384);
    const int gw = blockIdx.x * NWAVES + wave, NGW = G * NWAVES;
    constexpr int I_IN = 32 * (INP / 32), I_OUT = 32 * 64, I_13 = 32 * (2 * DFF / 32), I_2 = (DFF / 64) * 64, I_MEM = 32 * 32, I_L = I_IN + I_OUT + I_13 + I_2 + I_MEM;
    unsigned char* ws = a.ws;
    for (int it = gw; it < DEPTH * I_L; it += NGW) {
        const int l = it / I_L; int r = it % I_L;
        if (r < I_IN) { const int nb = r % (INP / 32), kb = r / (INP / 32);
            tr_item(a.in[3] + (size_t)l * DM * INC, INC, in_map(nb * 32), a.in[2] + l * DM, (bf16_t*)(ws + WS_WIN + l * SZ_WIN), DM, nb * 32, kb * 64, scr, lane); continue; }
        r -= I_IN;
        if (r < I_OUT) { const int nb = r % 64, kb = r / 64;
            tr_item(a.in[18] + (size_t)l * DM * DM, DM, nb * 32, nullptr, (bf16_t*)(ws + WS_WOUT + l * SZ_WOUT), DM, nb * 32, kb * 64, scr, lane); continue; }
        r -= I_OUT;
        if (r < I_13) { const int nb = r % (2 * DFF / 32), kb = r / (2 * DFF / 32);
            tr_item(a.in[20] + (size_t)l * DM * 2 * DFF, 2 * DFF, w13_map(nb * 32), a.in[19] + l * DM, (bf16_t*)(ws + WS_W13 + l * SZ_W13), DM, nb * 32, kb * 64, scr, lane); continue; }
        r -= I_13;
        if (r < I_2) { const int nb = r % 64, kb = r / 64;
            tr_item(a.in[21] + (size_t)l * DFF * DM, DM, nb * 32, nullptr, (bf16_t*)(ws + WS_W2 + l * SZ_W2), DFF, nb * 32, kb * 64, scr, lane); continue; }
        r -= I_2;
        { const int nb = r % 32, kb = r / 32;
            tr_item(a.in[14] + (size_t)l * DM * 1024, 1024, nb * 32, a.in[13] + l * DM, (bf16_t*)(ws + WS_WMEM), DM, l * 1024 + nb * 32, kb * 64, scr, lane); }
    }
    for (int idx = gw * 64 + lane; idx < DEPTH * 2 * 512; idx += NGW * 64) {
        const int dd = idx & 511, dir = (idx >> 9) & 1, ll = idx >> 10;
        const GAS float* src = (const GAS float*)a.in[dir ? 6 : 4] + (size_t)ll * 16 * 512 + dd;
        u32x4 w0, w1;
        w0.x = cvt_pk_bf16(src[0 * 512], src[1 * 512]); w0.y = cvt_pk_bf16(src[2 * 512], src[3 * 512]); w0.z = cvt_pk_bf16(src[4 * 512], src[5 * 512]); w0.w = cvt_pk_bf16(src[6 * 512], src[7 * 512]);
        w1.x = cvt_pk_bf16(src[8 * 512], src[9 * 512]); w1.y = cvt_pk_bf16(src[10 * 512], src[11 * 512]); w1.z = cvt_pk_bf16(src[12 * 512], src[13 * 512]); w1.w = cvt_pk_bf16(src[14 * 512], src[15 * 512]);
        GAS u32x4* dst = (GAS u32x4*)(ws + WS_WG2T + (size_t)idx * 64);
        dst[0] = w0; dst[1] = w1; dst[2] = (u32x4){0u, 0u, 0u, 0u}; dst[3] = (u32x4){0u, 0u, 0u, 0u};
    }
    bf16_t* XB = (bf16_t*)(ws + WS_XB); float* SSQ = (float*)(ws + WS_SSQ); bf16_t* MEMN = (bf16_t*)(ws + WS_MEMN);
    for (int row = gw; row < MTOK + BATCH * MEMT; row += NGW) {
        const bool isx = row < MTOK; const int rr = isx ? row : row - MTOK;
        const f32x4* xr = (const f32x4*)((isx ? a.in[0] : a.in[1]) + (size_t)rr * DM) + lane;
        f32x4 v[8]; float s = 0.f;
#pragma unroll
        for (int j = 0; j < 8; ++j) { v[j] = xr[64 * j]; s += dot4(v[j]); }
        s = wave_sum(s);
        float sc = 1.0f;
        if (isx) { if (lane < 32) SSQ[(size_t)rr * 32 + lane] = lane == 0 ? s : 0.f; }
        else sc = rsqrtf(s * (1.0f / DM) + EPS);
        u32x2* o = (u32x2*)((isx ? XB : MEMN) + (size_t)rr * DM) + lane;
#pragma unroll
        for (int j = 0; j < 8; ++j) o[64 * j] = pk4(v[j] * sc);
    }
}

__device__ __forceinline__ void memprep(const Args& a, int G) {
    const int lane = tidx() & 63, wave = tidx() >> 6;
    const int gw = blockIdx.x * NWAVES + wave, NGW = G * NWAVES;
    const bf16_t* MKV = (const bf16_t*)(a.ws + WS_MKV); bf16_t* KM = (bf16_t*)(a.ws + WS_KM); bf16_t* VMT = (bf16_t*)(a.ws + WS_VMT);
    for (int it = gw; it < DEPTH * BATCH * 4 * MEMT; it += NGW) {
        const int key = it & 255, h = (it >> 8) & 3, b = (it >> 10) & 1, l = it >> 11;
        const bf16_t* src = MKV + (size_t)(b * 256 + key) * 4096 + l * 1024 + h * 128 + 2 * lane;
        const unsigned kw = *(const unsigned*)src, vw = *(const unsigned*)(src + 512);
        const float k0 = bflo(kw), k1 = bfhi(kw);
        const float ss = wave_sum(k0 * k0 + k1 * k1);
        const float r = rsqrtf(ss * (1.0f / 128.0f) + EPS) * 0.08838834764831845f;
        const float* gk = a.in[16] + l * 128 + 2 * lane; const float* gq = a.in[15] + l * 128 + 2 * lane;
        const size_t hb = (size_t)((l * 2 + b) * 4 + h) * 32768;
        *(unsigned*)(KM + hb + key * 128 + 2 * lane) = cvt_pk_bf16(k0 * r * gk[0] * gq[0], k1 * r * gk[1] * gq[1]);
        VMT[hb + (size_t)(2 * lane) * 256 + key] = (bf16_t)(vw & 0xffffu);
        VMT[hb + (size_t)(2 * lane + 1) * 256 + key] = (bf16_t)(vw >> 16);
    }
}

template <int D, bool IS_NA>
__device__ __forceinline__ void attn16(const bf16_t* qrow, const bf16_t* kbase, long kstride, int key0, int krstep,
                                       const bf16_t* vtbase, long vtstride, int vkey0,
                                       const LAS float* rpbh, int r, int rs, int j, int kc0,
                                       const float* ogain, bf16_t* y0, int fr, int fq) {
    bf16x8 qf[D / 32];
#pragma unroll
    for (int ks = 0; ks < D / 32; ++ks) qf[ks] = *(const GAS bf16x8*)((const GAS bf16_t*)qrow + 32 * ks + 8 * fq);
    float qscale = 1.0f;
    if (!IS_NA) {
        float ss = 0.f;
#pragma unroll
        for (int ks = 0; ks < D / 32; ++ks) { const u32x4 w = __builtin_bit_cast(u32x4, qf[ks]);
#pragma unroll
            for (int e = 0; e < 4; ++e) { const float lo = bflo(w[e]), hi = bfhi(w[e]); ss += lo * lo + hi * hi; } }
        ss = fq_sum(ss);
        qscale = rsqrtf(ss * (1.0f / D) + EPS);
    }
    f32x4 s[16];
    const int kro = 8 * (fr >> 2) + (fr & 3);
    constexpr int NK = D / 32, GT = 8 / NK;
    const GAS bf16_t* kb0 = (const GAS bf16_t*)kbase + (long)(key0 + kro) * kstride + 8 * fq;
    bf16x8 kf[2][GT][NK];
#define ATT_LDK(buf, g) do { _Pragma("unroll") for (int tt_ = 0; tt_ < GT; ++tt_) { const int t_ = (g) * GT + tt_, kr_ = t_ >> 1, u_ = t_ & 1; \
        const GAS bf16_t* kp_ = kb0 + (long)(kr_ * krstep + 4 * u_) * kstride; \
        _Pragma("unroll") for (int ks_ = 0; ks_ < NK; ++ks_) kf[buf][tt_][ks_] = *(const GAS bf16x8*)(kp_ + 32 * ks_); } } while (0)
    ATT_LDK(0, 0);
#pragma unroll
    for (int g = 0; g < 16 / GT; ++g) {
        if (g + 1 < 16 / GT) ATT_LDK((g + 1) & 1, g + 1);
#pragma unroll
        for (int tt = 0; tt < GT; ++tt) { f32x4 acc = (f32x4){0.f, 0.f, 0.f, 0.f};
#pragma unroll
            for (int ks = 0; ks < NK; ++ks) acc = mfma16(kf[g & 1][tt][ks], qf[ks], acc);
            s[g * GT + tt] = acc; }
    }
#undef ATT_LDK
    float mx = -INFINITY;
    if (IS_NA) {
        const int qcol = 16 * j + fr; const int cs = min(max(qcol - 8, 0), 48);
#pragma unroll
        for (int t = 0; t < 16; ++t) {
            const int kr = t >> 1, u = t & 1, dr = rs + kr - r + 7;
#pragma unroll
            for (int i = 0; i < 4; ++i) {
                const int kcol = kc0 + 8 * fq + 4 * u + i; const bool valid = kcol >= cs && kcol < cs + 16;
                const int dc = min(max(kcol - qcol + 15, 0), 30);
                const float v = valid ? s[t][i] + rpbh[dr * 31 + dc] : -INFINITY;
                s[t][i] = v; mx = fmaxf(mx, v);
            }
        }
    } else {
#pragma unroll
        for (int t = 0; t < 16; ++t)
#pragma unroll
            for (int i = 0; i < 4; ++i) { const float v = s[t][i] * qscale; s[t][i] = v; mx = fmaxf(mx, v); }
    }
    mx = fq_max(mx);
    float sum = 0.f;
#pragma unroll
    for (int t = 0; t < 16; ++t)
#pragma unroll
        for (int i = 0; i < 4; ++i) { const float p = __expf(s[t][i] - mx); s[t][i] = p; sum += p; }
    sum = fq_sum(sum);
    const float inv = 1.0f / sum;
    f32x4 o[D / 16];
#pragma unroll
    for (int nd = 0; nd < D / 16; ++nd) o[nd] = (f32x4){0.f, 0.f, 0.f, 0.f};
    const GAS bf16_t* vb0 = (const GAS bf16_t*)vtbase + (long)fr * vtstride + vkey0 + 8 * fq;
    bf16x8 vf[2][D / 16];
#pragma unroll
    for (int nd = 0; nd < D / 16; ++nd) vf[0][nd] = *(const GAS bf16x8*)(vb0 + (long)(16 * nd) * vtstride);
#pragma unroll
    for (int kr = 0; kr < 8; ++kr) {
        if (kr + 1 < 8) {
#pragma unroll
            for (int nd = 0; nd < D / 16; ++nd) vf[(kr + 1) & 1][nd] = *(const GAS bf16x8*)(vb0 + (kr + 1) * krstep + (long)(16 * nd) * vtstride); }
        const bf16x8 pa = pk8(s[2 * kr] * inv, s[2 * kr + 1] * inv);
#pragma unroll
        for (int nd = 0; nd < D / 16; ++nd) o[nd] = mfma16(pa, vf[kr & 1][nd], o[nd]);
    }
    float ro[4];
#pragma unroll
    for (int i = 0; i < 4; ++i) { float ss = 0.f;
#pragma unroll
        for (int nd = 0; nd < D / 16; ++nd) ss += o[nd][i] * o[nd][i];
        ss = fr_sum(ss); ro[i] = rsqrtf(ss * (1.0f / D) + EPS); }
#pragma unroll
    for (int nd = 0; nd < D / 16; ++nd) { const float g = ogain[16 * nd + fr];
#pragma unroll
        for (int i = 0; i < 4; ++i) y0[(size_t)(4 * fq + i) * DM + 16 * nd + fr] = f2bf(o[nd][i] * ro[i] * g); }
}

constexpr int GL_CUMF = 8192, GL_CUMB = GL_CUMF + 32768, GL_VTA = GL_CUMB + 32768, GL_KTF = GL_VTA + 36864, GL_KTB = GL_KTF + 18432;
constexpr int GL_G = 0, GL_CUM = 4096, GL_VT = GL_CUM + 32768, GL_KT = GL_VT + 36864, GL_QE = GL_KT, GL_KE = GL_QE + 17408, GL_RED = GL_KE + 17408;
constexpr int VTS = 72, QES = 136;

__device__ __forceinline__ void gla_cum(const Args& a, LAS unsigned char* lds, int l, int h, int t0, int dir) {
    const int tid = tidx();
    LAS float* Gs = (LAS float*)(lds + GL_G); LAS float* CUM = (LAS float*)(lds + GL_CUM);
    const bf16_t* P = (const bf16_t*)(a.ws + WS_P);
    if (tid < 128) { const int s = tid >> 1, hf = tid & 1;
        const u32x4 w = *(const u32x4*)(P + (size_t)(t0 + s) * INP + C_GG + 16 * dir + 8 * hf);
        LAS float* g = Gs + s * 16 + 8 * hf;
#pragma unroll
        for (int e = 0; e < 4; ++e) { g[2 * e] = bflo(w[e]); g[2 * e + 1] = bfhi(w[e]); } }
    const int d = tid & 127, sg = tid >> 7;
    const float* wg = a.in[dir ? 6 : 4] + (size_t)l * 16 * 512 + 128 * h + d;
    float w[16];
#pragma unroll
    for (int jj = 0; jj < 16; ++jj) w[jj] = wg[jj * 512];
    const float bias = a.in[dir ? 7 : 5][l * 512 + 128 * h + d];
    __syncthreads();
#pragma unroll 4
    for (int i = 0; i < 16; ++i) { const int s = sg * 16 + i; const LAS f32x4* g4 = (const LAS f32x4*)(Gs + s * 16);
        float z = bias;
#pragma unroll
        for (int q = 0; q < 4; ++q) { const f32x4 g = g4[q]; z += g[0] * w[4 * q] + g[1] * w[4 * q + 1] + g[2] * w[4 * q + 2] + g[3] * w[4 * q + 3]; }
        const float ls = fminf(z, 0.f) - __logf(1.0f + __expf(-fabsf(z)));
        CUM[s * 128 + d] = ls * (1.0f / 16.0f); }
    __syncthreads();
    if (tid < 256) { const int hf = tid >> 7; float run = 0.f;
#pragma unroll 8
        for (int p = 0; p < 32; ++p) { const int pp = 32 * hf + p, s = dir ? 63 - pp : pp; run += CUM[s * 128 + d]; CUM[s * 128 + d] = run; } }
    __syncthreads();
    { const int sl = dir ? 32 : 31; const float tot = CUM[sl * 128 + d];
#pragma unroll
      for (int i = 0; i < 8; ++i) { const int pp = 32 + 8 * sg + i, s = dir ? 63 - pp : pp; CUM[s * 128 + d] += tot; } }
    __syncthreads();
}

__device__ __forceinline__ void gla_vt(const Args& a, LAS unsigned char* lds, int h, int t0) {
    const int tid = tidx(), e = tid & 255, sg = tid >> 8;
    const bf16_t* P = (const bf16_t*)(a.ws + WS_P) + (size_t)t0 * INP + C_GV + 256 * h + e;
    LAS bf16_t* VT = (LAS bf16_t*)(lds + GL_VT);
#pragma unroll
    for (int it = 0; it < 4; ++it) { const int s0 = 8 * (sg + 2 * it); unsigned short v[8];
#pragma unroll
        for (int i = 0; i < 8; ++i) v[i] = P[(size_t)(s0 + i) * INP];
        u32x4 w; w.x = v[0] | ((unsigned)v[1] << 16); w.y = v[2] | ((unsigned)v[3] << 16); w.z = v[4] | ((unsigned)v[5] << 16); w.w = v[6] | ((unsigned)v[7] << 16);
        *(LAS u32x4*)(VT + e * VTS + s0) = w; }
}

struct GlaVtRegs { unsigned short v[4][8]; };
__device__ __forceinline__ void gla_vt_load(const Args& a, GlaVtRegs& R, int h, int t0) {
    const int tid = tidx(), e = tid & 255, sg = tid >> 8;
    const GAS bf16_t* P = (const GAS bf16_t*)(a.ws + WS_P) + (size_t)t0 * INP + C_GV + 256 * h + e;
#pragma unroll
    for (int it = 0; it < 4; ++it)
#pragma unroll
        for (int i = 0; i < 8; ++i) R.v[it][i] = P[(size_t)(8 * (sg + 2 * it) + i) * INP];
}
__device__ __forceinline__ void gla_vt_store(const GlaVtRegs& R, LAS bf16_t* VT) {
    const int tid = tidx(), e = tid & 255, sg = tid >> 8;
#pragma unroll
    for (int it = 0; it < 4; ++it) { const int s0 = 8 * (sg + 2 * it);
        u32x4 w; w.x = R.v[it][0] | ((unsigned)R.v[it][1] << 16); w.y = R.v[it][2] | ((unsigned)R.v[it][3] << 16); w.z = R.v[it][4] | ((unsigned)R.v[it][5] << 16); w.w = R.v[it][6] | ((unsigned)R.v[it][7] << 16);
        *(LAS u32x4*)(VT + e * VTS + s0) = w; }
}

struct GlaGateRegs { bf16x8 af, ab, wfr[4], wbr[4]; float bfv[4], bbv[4]; };
__device__ __forceinline__ void gla_gate_load(const Args& a, GlaGateRegs& R, int l, int h, int t0, int wave, int fr, int fq) {
    const int mt = wave & 3, dh = wave >> 2;
    const GAS bf16_t* gp = (const GAS bf16_t*)(a.ws + WS_P) + (size_t)(t0 + 16 * mt + fr) * INP + C_GG;
    R.af = *(const GAS bf16x8*)(gp + 8 * fq); R.ab = *(const GAS bf16x8*)(gp + ((8 * fq + 16) & 31));
    const GAS bf16_t* wt = (const GAS bf16_t*)(a.ws + WS_WG2T) + ((size_t)(l * 2) * 512 + 128 * h + 64 * dh + fr) * 32 + 8 * fq;
#pragma unroll
    for (int dt = 0; dt < 4; ++dt) { R.wfr[dt] = *(const GAS bf16x8*)(wt + dt * 16 * 32); R.wbr[dt] = *(const GAS bf16x8*)(wt + 512 * 32 + dt * 16 * 32);
        R.bfv[dt] = a.in[5][l * 512 + 128 * h + 64 * dh + 16 * dt + fr]; R.bbv[dt] = a.in[7][l * 512 + 128 * h + 64 * dh + 16 * dt + fr]; }
}
__device__ __forceinline__ void gla_gate_compute(const GlaGateRegs& R, LAS float* CF, LAS float* CB, int wave, int fr, int fq) {
    const int mt = wave & 3, dh = wave >> 2;
#pragma unroll
    for (int dt = 0; dt < 4; ++dt) {
        const f32x4 zf = mfma16(R.af, R.wfr[dt], (f32x4){0.f, 0.f, 0.f, 0.f}), zb = mfma16(R.ab, R.wbr[dt], (f32x4){0.f, 0.f, 0.f, 0.f});
        const int dcol = 64 * dh + 16 * dt + fr;
#pragma unroll
        for (int i = 0; i < 4; ++i) { const int srow = 16 * mt + 4 * fq + i; const float vf = zf[i] + R.bfv[dt], vb = zb[i] + R.bbv[dt];
            CF[srow * 128 + dcol] = (fminf(vf, 0.f) - __logf(1.0f + __expf(-fabsf(vf)))) * (1.0f / 16.0f);
            CB[srow * 128 + dcol] = (fminf(vb, 0.f) - __logf(1.0f + __expf(-fabsf(vb)))) * (1.0f / 16.0f); }
    }
}

__device__ __forceinline__ void gla_a_unit(const Args& a, LAS unsigned char* lds, int l, int unit) {
    const int tid = tidx(), lane = tid & 63, wave = tid >> 6, fr = lane & 15, fq = lane >> 4;
    const int n = unit & 127, h = (unit >> 7) & 3, b = unit >> 9, t0 = b * SEQ + n * 64;
    const int d = tid & 127, sg = tid >> 7;
    const GAS bf16_t* P = (const GAS bf16_t*)(a.ws + WS_P);
    LAS float* Gs = (LAS float*)(lds + GL_G); LAS float* CF = (LAS float*)(lds + GL_CUMF); LAS float* CB = (LAS float*)(lds + GL_CUMB);
    LAS bf16_t* VT = (LAS bf16_t*)(lds + GL_VTA); LAS bf16_t* KTF = (LAS bf16_t*)(lds + GL_KTF); LAS bf16_t* KTB = (LAS bf16_t*)(lds + GL_KTB);
    GAS bf16_t* ST = (GAS bf16_t*)(a.ws + WS_ST); GAS float* DEC = (GAS float*)(a.ws + WS_DEC);
    GlaGateRegs GR; gla_gate_load(a, GR, l, h, t0, wave, fr, fq);
    GlaVtRegs VR; gla_vt_load(a, VR, h, t0);
    __syncthreads();
    gla_vt_store(VR, VT);
    unsigned short kv[2][8];
    { const GAS bf16_t* kp = P + (size_t)t0 * INP + C_GK + 128 * h + d;
#pragma unroll
      for (int it = 0; it < 2; ++it)
#pragma unroll
          for (int i = 0; i < 8; ++i) kv[it][i] = kp[(size_t)(8 * (sg + 4 * it) + i) * INP]; }
    gla_gate_compute(GR, CF, CB, wave, fr, fq);
    __syncthreads();
    { const int dir = tid >> 8, hf = (tid >> 7) & 1; LAS float* C = dir ? CB : CF; float run = 0.f;
#pragma unroll 8
      for (int p = 0; p < 32; ++p) { const int pp = 32 * hf + p, s = dir ? 63 - pp : pp; run += C[s * 128 + d]; C[s * 128 + d] = run; } }
    __syncthreads();
    { const float tf = CF[31 * 128 + d], tb = CB[32 * 128 + d];
#pragma unroll
      for (int i = 0; i < 8; ++i) { const int pp = 32 + 8 * sg + i; CF[pp * 128 + d] += tf; CB[(63 - pp) * 128 + d] += tb; } }
    __syncthreads();
    { const float lf = CF[63 * 128 + d], lb = CB[d];
#pragma unroll
      for (int it = 0; it < 2; ++it) { const int s0 = 8 * (sg + 4 * it); float vf[8], vb[8];
#pragma unroll
          for (int i = 0; i < 8; ++i) { const float k = bf2f(kv[it][i]); vf[i] = k * __expf(lf - CF[(s0 + i) * 128 + d]); vb[i] = k * __expf(lb - CB[(s0 + i) * 128 + d]); }
          u32x4 w; w.x = cvt_pk_bf16(vf[0], vf[1]); w.y = cvt_pk_bf16(vf[2], vf[3]); w.z = cvt_pk_bf16(vf[4], vf[5]); w.w = cvt_pk_bf16(vf[6], vf[7]);
          *(LAS u32x4*)(KTF + d * VTS + s0) = w;
          w.x = cvt_pk_bf16(vb[0], vb[1]); w.y = cvt_pk_bf16(vb[2], vb[3]); w.z = cvt_pk_bf16(vb[4], vb[5]); w.w = cvt_pk_bf16(vb[6], vb[7]);
          *(LAS u32x4*)(KTB + d * VTS + s0) = w; }
      if (tid < 128) { DEC[((size_t)unit * 2 + 0) * 128 + d] = __expf(lf); DEC[((size_t)unit * 2 + 1) * 128 + d] = __expf(lb); }
    }
    __syncthreads();
    bf16x8 vb[2][2];
#pragma unroll
    for (int et = 0; et < 2; ++et)
#pragma unroll
        for (int ks = 0; ks < 2; ++ks) vb[et][ks] = *(const LAS bf16x8*)(VT + (32 * wave + 16 * et + fr) * VTS + 32 * ks + 8 * fq);
#pragma unroll
    for (int dir = 0; dir < 2; ++dir) { const LAS bf16_t* KT = dir ? KTB : KTF; GAS bf16_t* stp = ST + ((size_t)unit * 2 + dir) * 32768;
#pragma unroll
        for (int dt = 0; dt < 8; ++dt) {
            bf16x8 ka[2];
#pragma unroll
            for (int ks = 0; ks < 2; ++ks) ka[ks] = *(const LAS bf16x8*)(KT + (16 * dt + fr) * VTS + 32 * ks + 8 * fq);
#pragma unroll
            for (int et = 0; et < 2; ++et) { f32x4 acc = (f32x4){0.f, 0.f, 0.f, 0.f};
                acc = mfma16(ka[0], vb[et][0], acc); acc = mfma16(ka[1], vb[et][1], acc);
                *(GAS u32x2*)(stp + (size_t)(((2 * wave + et) * 8 + dt) * 256 + fr * 16 + 4 * fq)) = pk4(acc); }
        } }
}

__device__ __forceinline__ void gla_scan(const Args& a, int G) {
    const GAS bf16_t* ST = (const GAS bf16_t*)(a.ws + WS_ST); GAS bf16_t* ST2 = (GAS bf16_t*)(a.ws + WS_ST2); const GAS float* DEC = (const GAS float*)(a.ws + WS_DEC);
    for (int gid = blockIdx.x * NTHR + tidx(); gid < 16 * 8192; gid += G * NTHR) {
        const int seq = gid >> 13, off = (gid & 8191) * 4, dir = seq & 1, bh = seq >> 1, d = 16 * ((off >> 8) & 7) + (off & 15);
        f32x4 st = (f32x4){0.f, 0.f, 0.f, 0.f};
        for (int s0 = 0; s0 < 128; s0 += 8) {
            u32x2 kv[8]; f32x4 dc[8];
#pragma unroll
            for (int j = 0; j < 8; ++j) { const int n = dir ? 127 - (s0 + j) : (s0 + j); const size_t u2 = (size_t)(bh * 128 + n) * 2 + dir;
                kv[j] = *(const GAS u32x2*)(ST + u2 * 32768 + off); dc[j] = *(const GAS f32x4*)(DEC + u2 * 128 + d); }
#pragma unroll
            for (int j = 0; j < 8; ++j) { const int n = dir ? 127 - (s0 + j) : (s0 + j); const size_t u2 = (size_t)(bh * 128 + n) * 2 + dir;
                *(GAS u32x2*)(ST2 + u2 * 32768 + off) = pk4(st);
                st[0] = dc[j][0] * st[0] + bflo(kv[j].x); st[1] = dc[j][1] * st[1] + bfhi(kv[j].x); st[2] = dc[j][2] * st[2] + bflo(kv[j].y); st[3] = dc[j][3] * st[3] + bfhi(kv[j].y); }
        }
    }
}

constexpr int GL2_G = 0, GL2_CF = 8192, GL2_CB = GL2_CF + 32768, GL2_VT = GL2_CB + 32768, GL2_QE = GL2_VT + 36864, GL2_KE = GL2_QE + 17408;
__device__ __forceinline__ void gla_c_unit(const Args& a, LAS unsigned char* lds, int l, int unit) {
    const int tid = tidx(), lane = tid & 63, wave = tid >> 6, fr = lane & 15, fq = lane >> 4;
    const int n = unit & 127, h = (unit >> 7) & 3, b = unit >> 9, t0 = b * SEQ + n * 64;
    const int tt = wave & 3, eh = wave >> 2, d = tid & 127, sg = tid >> 7;
    const GAS bf16_t* P = (const GAS bf16_t*)(a.ws + WS_P);
    LAS float* Gs = (LAS float*)(lds + GL2_G); LAS float* CF = (LAS float*)(lds + GL2_CF); LAS float* CB = (LAS float*)(lds + GL2_CB);
    LAS bf16_t* VT = (LAS bf16_t*)(lds + GL2_VT); LAS bf16_t* QE = (LAS bf16_t*)(lds + GL2_QE); LAS bf16_t* KE = (LAS bf16_t*)(lds + GL2_KE); LAS float* RED = (LAS float*)(lds + GL2_G);
    const GAS bf16_t* ST = (const GAS bf16_t*)(a.ws + WS_ST2);
    f32x4 o[2][4];
#pragma unroll
    for (int et = 0; et < 2; ++et)
#pragma unroll
        for (int tq = 0; tq < 4; ++tq) o[et][tq] = (f32x4){0.f, 0.f, 0.f, 0.f};
    bf16x8 sf[2][2][4];
    const GAS bf16x8* sp0 = (const GAS bf16x8*)(ST + (size_t)unit * 2 * 32768 + (size_t)(2 * wave * 8 + (fq >> 1)) * 256 + fr * 16 + 8 * (fq & 1));
    {
#pragma unroll
      for (int et = 0; et < 2; ++et)
#pragma unroll
          for (int ks = 0; ks < 4; ++ks) sf[0][et][ks] = sp0[et * 256 + ks * 64]; }
    u32x2 rw[2][4];
    const int sb = tid >> 3, d0 = 16 * (tid & 7);
    u32x4 qw[2], kw[2];
    { const GAS u32x4* qp = (const GAS u32x4*)(P + (size_t)(t0 + sb) * INP + C_GQ + 128 * h + d0); const GAS u32x4* kp = (const GAS u32x4*)(P + (size_t)(t0 + sb) * INP + C_GK + 128 * h + d0);
      qw[0] = qp[0]; qw[1] = qp[1]; kw[0] = kp[0]; kw[1] = kp[1]; }
    GlaGateRegs GR; gla_gate_load(a, GR, l, h, t0, wave, fr, fq);
    GlaVtRegs VR; gla_vt_load(a, VR, h, t0);
    __syncthreads();
    gla_vt_store(VR, VT);
    gla_gate_compute(GR, CF, CB, wave, fr, fq);
    __syncthreads();
    { const int dir = tid >> 8, hf = (tid >> 7) & 1; LAS float* C = dir ? CB : CF; float run = 0.f;
#pragma unroll 8
      for (int p = 0; p < 32; ++p) { const int pp = 32 * hf + p, s = dir ? 63 - pp : pp; run += C[s * 128 + d]; C[s * 128 + d] = run; } }
    __syncthreads();
    { const float tf = CF[31 * 128 + d], tb = CB[32 * 128 + d];
#pragma unroll
      for (int i = 0; i < 8; ++i) { const int pp = 32 + 8 * sg + i; CF[pp * 128 + d] += tf; CB[(63 - pp) * 128 + d] += tb; } }
    __syncthreads();
    const int t = 16 * tt + fr;
#pragma unroll
    for (int dir = 0; dir < 2; ++dir) {
        { const LAS float* C = dir ? CB : CF;
#pragma unroll
          for (int c = 0; c < 2; ++c) { const LAS f32x4* cp = (const LAS f32x4*)(C + sb * 128 + d0 + 8 * c); const f32x4 c0 = cp[0], c1 = cp[1];
              const float cv[8] = {c0[0], c0[1], c0[2], c0[3], c1[0], c1[1], c1[2], c1[3]}; u32x4 qo, ko;
#pragma unroll
              for (int e = 0; e < 4; ++e) {
                  qo[e] = cvt_pk_bf16(bflo(qw[c][e]) * __expf(cv[2 * e]), bfhi(qw[c][e]) * __expf(cv[2 * e + 1]));
                  ko[e] = cvt_pk_bf16(bflo(kw[c][e]) * __expf(-cv[2 * e]), bfhi(kw[c][e]) * __expf(-cv[2 * e + 1])); }
              *(LAS u32x4*)(QE + sb * QES + d0 + 8 * c) = qo; *(LAS u32x4*)(KE + sb * QES + d0 + 8 * c) = ko; } }
        __syncthreads();
        bf16x8 pb[4][2];
#pragma unroll
        for (int sgi = 0; sgi < 2; ++sgi) {
            bf16x8 kf[2][4];
#pragma unroll
            for (int u = 0; u < 2; ++u) { const int srow = 32 * sgi + 8 * (fr >> 2) + (fr & 3) + 4 * u;
#pragma unroll
                for (int ks = 0; ks < 4; ++ks) kf[u][ks] = *(const LAS bf16x8*)(KE + srow * QES + 32 * ks + 8 * fq); }
#pragma unroll
            for (int tq = 0; tq < 4; ++tq) { const int tcol = 16 * tq + fr; bf16x8 qf[4]; f32x4 sc[2];
#pragma unroll
                for (int ks = 0; ks < 4; ++ks) qf[ks] = *(const LAS bf16x8*)(QE + (16 * tq + fr) * QES + 32 * ks + 8 * fq);
#pragma unroll
                for (int u = 0; u < 2; ++u) { f32x4 acc = (f32x4){0.f, 0.f, 0.f, 0.f};
#pragma unroll
                    for (int ks = 0; ks < 4; ++ks) acc = mfma16(kf[u][ks], qf[ks], acc);
#pragma unroll
                    for (int i = 0; i < 4; ++i) { const int srow = 32 * sgi + 8 * fq + 4 * u + i; const bool keep = dir ? (srow > tcol) : (srow <= tcol); acc[i] = keep ? acc[i] : 0.f; }
                    sc[u] = acc; }
                pb[tq][sgi] = pk8(sc[0], sc[1]); } }
        if (dir == 0) {
#pragma unroll
            for (int et = 0; et < 2; ++et)
#pragma unroll
                for (int ks = 0; ks < 4; ++ks) sf[1][et][ks] = sp0[4096 + et * 256 + ks * 64];
        } else {
            const GAS bf16_t* rp = P + (size_t)(t0 + fr) * INP + C_GR + 256 * h + 32 * wave + 4 * fq;
#pragma unroll
            for (int et = 0; et < 2; ++et)
#pragma unroll
                for (int tq = 0; tq < 4; ++tq) rw[et][tq] = *(const GAS u32x2*)(rp + (size_t)(16 * tq) * INP + 16 * et); }
        bf16x8 vf[2][2];
#pragma unroll
        for (int et = 0; et < 2; ++et)
#pragma unroll
            for (int sgi = 0; sgi < 2; ++sgi) vf[et][sgi] = *(const LAS bf16x8*)(VT + (32 * wave + 16 * et + fr) * VTS + 32 * sgi + 8 * fq);
#pragma unroll
        for (int tq = 0; tq < 4; ++tq) { bf16x8 qf[4];
#pragma unroll
            for (int ks = 0; ks < 4; ++ks) qf[ks] = *(const LAS bf16x8*)(QE + (16 * tq + fr) * QES + 32 * ks + 8 * fq);
#pragma unroll
            for (int et = 0; et < 2; ++et) { f32x4 acc = o[et][tq];
#pragma unroll
                for (int sgi = 0; sgi < 2; ++sgi) acc = mfma16(vf[et][sgi], pb[tq][sgi], acc);
#pragma unroll
                for (int ks = 0; ks < 4; ++ks) acc = mfma16(sf[dir][et][ks], qf[ks], acc);
                o[et][tq] = acc; } }
        if (dir == 0) __syncthreads();
    }
#pragma unroll
    for (int tq = 0; tq < 4; ++tq) { float ss = dot4(o[0][tq]) + dot4(o[1][tq]); ss = fq_sum(ss); if (fq == 0) RED[wave * 64 + 16 * tq + fr] = ss; }
    __syncthreads();
    const float* gn = a.in[8] + l * 1024 + 256 * h; GAS bf16_t* Y = (GAS bf16_t*)(a.ws + WS_Y);
#pragma unroll
    for (int tq = 0; tq < 4; ++tq) { const int t = 16 * tq + fr; float tot = 0.f;
#pragma unroll
        for (int w8 = 0; w8 < 8; ++w8) tot += RED[w8 * 64 + t];
        const float rstd = rsqrtf(tot * (1.0f / 256.0f) + EPS);
#pragma unroll
        for (int et = 0; et < 2; ++et) { const int e = 32 * wave + 16 * et + 4 * fq;
            const f32x4 g = *(const f32x4*)(gn + e);
            const float r4[4] = {bflo(rw[et][tq].x), bfhi(rw[et][tq].x), bflo(rw[et][tq].y), bfhi(rw[et][tq].y)}; f32x4 y;
#pragma unroll
            for (int i = 0; i < 4; ++i) y[i] = o[et][tq][i] * rstd * g[i] * (r4[i] * __builtin_amdgcn_rcpf(1.0f + __expf(-r4[i])));
            *(GAS u32x2*)(Y + (size_t)(t0 + t) * DM + 256 * h + e) = pk4(y); } }
}

constexpr int NA_RPB = 147456, NA_VL = 73728;
__device__ __forceinline__ void na_attn_block(const Args& a, LAS unsigned char* lds, int l, int u) {
    const int tid = tidx(), lane = tid & 63, wave = tid >> 6, fr = lane & 15, fq = lane >> 4;
    const int b = u >> 9, h = (u >> 6) & 7, r0 = 2 * (u & 63), r = r0 + (wave >> 2), j = wave & 3;
    const int rs0 = min(max(r0 - 4, 0), 120), rs = min(max(r - 4, 0), 120), krw = rs - rs0, kc0 = min(max(16 * j - 8, 0), 32);
    const int tq0 = b * SEQ + r * 64 + 16 * j;
    const GAS bf16_t* P = (const GAS bf16_t*)(a.ws + WS_P);
    LAS unsigned char* KL = lds; LAS unsigned char* VL = lds + NA_VL; LAS float* rpbh = (LAS float*)(lds + NA_RPB);
    bf16x8 qf[2];
    { const GAS bf16_t* qrow = P + (size_t)(tq0 + fr) * INP + C_NQ + 64 * h;
      qf[0] = *(const GAS bf16x8*)(qrow + 8 * fq); qf[1] = *(const GAS bf16x8*)(qrow + 32 + 8 * fq); }
    u32x4 kst[9], vst[9];
    { const GAS bf16_t* vg = (const GAS bf16_t*)(a.ws + WS_NVT) + (size_t)(b * 512 + 64 * h) * 8192 + rs0 * 64;
#pragma unroll
      for (int i = 0; i < 9; ++i) { const int ci = tid + 512 * i;
          { const int kk = ci >> 3, ch = ci & 7, trow = min(rs0 + (kk >> 6), 127);
            kst[i] = *(const GAS u32x4*)(P + (size_t)(b * SEQ + trow * 64 + (kk & 63)) * INP + C_NK + 64 * h + 8 * ch); }
          { const int dd = ci / 72, c = ci - dd * 72; vst[i] = *(const GAS u32x4*)(vg + (size_t)dd * 8192 + 8 * c); } } }
    const float rp = tid < 465 ? a.in[11][(l * 8 + h) * 465 + tid] : 0.f;
    __syncthreads();
#pragma unroll
    for (int i = 0; i < 9; ++i) { const int ci = tid + 512 * i;
        { const int kk = ci >> 3, ch = ci & 7, col = kk & 63, sw = ((col >> 1) & 1) | (((col >> 3) & 3) << 1); *(LAS u32x4*)(KL + kk * 128 + ((ch ^ sw) << 4)) = kst[i]; }
        { const int dd = ci / 72, c = ci - dd * 72; *(LAS u32x4*)(VL + dd * 1152 + ((c ^ ((dd >> 1) & 7)) << 4)) = vst[i]; } }
    if (tid < 465) rpbh[tid] = rp;
    __syncthreads();
    f32x4 s[16];
    const int kro = 8 * (fr >> 2) + (fr & 3);
#pragma unroll
    for (int t = 0; t < 16; ++t) { const int kr = t >> 1, u2 = t & 1, col = kc0 + kro + 4 * u2, sw = ((col >> 1) & 1) | (((col >> 3) & 3) << 1);
        const LAS unsigned char* kp = KL + ((krw + kr) * 64 + col) * 128; f32x4 acc = (f32x4){0.f, 0.f, 0.f, 0.f};
#pragma unroll
        for (int ks = 0; ks < 2; ++ks) acc = mfma16(*(const LAS bf16x8*)(kp + (((4 * ks + fq) ^ sw) << 4)), qf[ks], acc);
        s[t] = acc; }
    float mx = -INFINITY;
    { const int qcol = 16 * j + fr; const int cs = min(max(qcol - 8, 0), 48);
#pragma unroll
      for (int t = 0; t < 16; ++t) { const int kr = t >> 1, u2 = t & 1, dr = rs + kr - r + 7;
#pragma unroll
          for (int i = 0; i < 4; ++i) { const int kcol = kc0 + 8 * fq + 4 * u2 + i; const bool valid = kcol >= cs && kcol < cs + 16;
              const int dc = min(max(kcol - qcol + 15, 0), 30);
              const float v = valid ? s[t][i] + rpbh[dr * 31 + dc] : -INFINITY;
              s[t][i] = v; mx = fmaxf(mx, v); } } }
    mx = fq_max(mx);
    float sum = 0.f;
#pragma unroll
    for (int t = 0; t < 16; ++t)
#pragma unroll
        for (int i = 0; i < 4; ++i) { const float p = __expf(s[t][i] - mx); s[t][i] = p; sum += p; }
    sum = fq_sum(sum);
    const float inv = 1.0f / sum;
    f32x4 o[4];
#pragma unroll
    for (int nd = 0; nd < 4; ++nd) o[nd] = (f32x4){0.f, 0.f, 0.f, 0.f};
#pragma unroll
    for (int kr = 0; kr < 8; ++kr) { const bf16x8 pa = pk8(s[2 * kr] * inv, s[2 * kr + 1] * inv); const int c = (krw + kr) * 8 + (kc0 >> 3) + fq;
#pragma unroll
        for (int nd = 0; nd < 4; ++nd) o[nd] = mfma16(pa, *(const LAS bf16x8*)(VL + (16 * nd + fr) * 1152 + ((c ^ ((fr >> 1) & 7)) << 4)), o[nd]); }
    float ro[4];
#pragma unroll
    for (int i = 0; i < 4; ++i) { float q2 = 0.f;
#pragma unroll
        for (int nd = 0; nd < 4; ++nd) q2 += o[nd][i] * o[nd][i];
        q2 = fr_sum(q2); ro[i] = rsqrtf(q2 * (1.0f / 64.0f) + EPS); }
    const float* ogain = a.in[12] + l * 512 + 64 * h; GAS bf16_t* y0 = (GAS bf16_t*)(a.ws + WS_Y) + (size_t)tq0 * DM + 1024 + 64 * h;
#pragma unroll
    for (int nd = 0; nd < 4; ++nd) { const float g = ogain[16 * nd + fr];
#pragma unroll
        for (int i = 0; i < 4; ++i) y0[(size_t)(4 * fq + i) * DM + 16 * nd + fr] = f2bf(o[nd][i] * ro[i] * g); }
}

__device__ __forceinline__ void mem_attn_block(const Args& a, LAS unsigned char* lds, int l, int u) {
    const int tid = tidx(), lane = tid & 63, wave = tid >> 6, fr = lane & 15, fq = lane >> 4;
    const int b = u >> 8, h = (u >> 6) & 3, qblk = u & 63, tq0 = b * SEQ + qblk * 128 + 16 * wave;
    const size_t hb = (size_t)((l * 2 + b) * 4 + h) * 32768;
    const GAS u32x4* kg = (const GAS u32x4*)((const GAS bf16_t*)(a.ws + WS_KM) + hb); const GAS u32x4* vg = (const GAS u32x4*)((const GAS bf16_t*)(a.ws + WS_VMT) + hb);
    LAS unsigned char* KL = lds; LAS unsigned char* VL = lds + 65536;
    const GAS bf16_t* qrow = (const GAS bf16_t*)(a.ws + WS_P) + (size_t)(tq0 + fr) * INP + C_MQ + 128 * h;
    bf16x8 qf[4];
#pragma unroll
    for (int ks = 0; ks < 4; ++ks) qf[ks] = *(const GAS bf16x8*)(qrow + 32 * ks + 8 * fq);
    u32x4 kst[8], vst[8];
#pragma unroll
    for (int i = 0; i < 8; ++i) { kst[i] = kg[tid + 512 * i]; vst[i] = vg[tid + 512 * i]; }
    __syncthreads();
#pragma unroll
    for (int i = 0; i < 8; ++i) { const int ci = tid + 512 * i;
        { const int key = ci >> 4, c = ci & 15, sw = (key & 3) | (((key >> 3) & 3) << 2); *(LAS u32x4*)(KL + key * 256 + ((c ^ sw) << 4)) = kst[i]; }
        { const int dd = ci >> 5, c = ci & 31; *(LAS u32x4*)(VL + dd * 512 + ((c ^ (dd & 15)) << 4)) = vst[i]; } }
    float ss = 0.f;
#pragma unroll
    for (int ks = 0; ks < 4; ++ks) { const u32x4 w = __builtin_bit_cast(u32x4, qf[ks]);
#pragma unroll
        for (int e = 0; e < 4; ++e) { const float lo = bflo(w[e]), hi = bfhi(w[e]); ss += lo * lo + hi * hi; } }
    ss = fq_sum(ss);
    const float qscale = rsqrtf(ss * (1.0f / 128.0f) + EPS);
    __syncthreads();
    f32x4 s[16];
    const int kro = 8 * (fr >> 2) + (fr & 3);
#pragma unroll
    for (int t = 0; t < 16; ++t) { const int R = 32 * (t >> 1) + kro + 4 * (t & 1), sw = (R & 3) | (((R >> 3) & 3) << 2);
        const LAS unsigned char* kp = KL + R * 256; f32x4 acc = (f32x4){0.f, 0.f, 0.f, 0.f};
#pragma unroll
        for (int ks = 0; ks < 4; ++ks) acc = mfma16(*(const LAS bf16x8*)(kp + (((4 * ks + fq) ^ sw) << 4)), qf[ks], acc);
        s[t] = acc; }
    float mx = -INFINITY;
#pragma unroll
    for (int t = 0; t < 16; ++t)
#pragma unroll
        for (int i = 0; i < 4; ++i) { const float v = s[t][i] * qscale; s[t][i] = v; mx = fmaxf(mx, v); }
    mx = fq_max(mx);
    float sum = 0.f;
#pragma unroll
    for (int t = 0; t < 16; ++t)
#pragma unroll
        for (int i = 0; i < 4; ++i) { const float p = __expf(s[t][i] - mx); s[t][i] = p; sum += p; }
    sum = fq_sum(sum);
    const float inv = 1.0f / sum;
    f32x4 o[8];
#pragma unroll
    for (int nd = 0; nd < 8; ++nd) o[nd] = (f32x4){0.f, 0.f, 0.f, 0.f};
#pragma unroll
    for (int kr = 0; kr < 8; ++kr) { const bf16x8 pa = pk8(s[2 * kr] * inv, s[2 * kr + 1] * inv);
#pragma unroll
        for (int nd = 0; nd < 8; ++nd) o[nd] = mfma16(pa, *(const LAS bf16x8*)(VL + (16 * nd + fr) * 512 + (((4 * kr + fq) ^ fr) << 4)), o[nd]); }
    float ro[4];
#pragma unroll
    for (int i = 0; i < 4; ++i) { float q2 = 0.f;
#pragma unroll
        for (int nd = 0; nd < 8; ++nd) q2 += o[nd][i] * o[nd][i];
        q2 = fr_sum(q2); ro[i] = rsqrtf(q2 * (1.0f / 128.0f) + EPS); }
    const float* ogain = a.in[17] + l * 512 + 128 * h; GAS bf16_t* y0 = (GAS bf16_t*)(a.ws + WS_Y) + (size_t)tq0 * DM + 1536 + 128 * h;
#pragma unroll
    for (int nd = 0; nd < 8; ++nd) { const float g = ogain[16 * nd + fr];
#pragma unroll
        for (int i = 0; i < 4; ++i) y0[(size_t)(4 * fq + i) * DM + 16 * nd + fr] = f2bf(o[nd][i] * ro[i] * g); }
}

__device__ __forceinline__ void gate_gemm(const Args& a, int l, int G) {
    const int tid = tidx(), lane = tid & 63, wave = tid >> 6, fr = lane & 15, fq = lane >> 4, mt = wave & 3, ct = wave >> 2;
    const GAS bf16_t* XB = (const GAS bf16_t*)(a.ws + WS_XB); const GAS bf16_t* Wg = (const GAS bf16_t*)(a.ws + WS_WIN + l * SZ_WIN) + (size_t)(5120 + 16 * ct + fr) * DM + 8 * fq;
    const GAS float* SSQ = (const GAS float*)(a.ws + WS_SSQ); GAS bf16_t* P = (GAS bf16_t*)(a.ws + WS_P);
    for (int it = blockIdx.x; it < MTOK / 64; it += G) {
        const int r0 = it * 64 + 16 * mt;
        const GAS bf16_t* ap = XB + (size_t)(r0 + fr) * DM + 8 * fq;
        f32x4 acc = (f32x4){0.f, 0.f, 0.f, 0.f};
#pragma unroll 1
        for (int k0 = 0; k0 < 64; k0 += 16) {
            bf16x8 af[16], bfr[16];
#pragma unroll
            for (int j = 0; j < 16; ++j) { af[j] = *(const GAS bf16x8*)(ap + 32 * (k0 + j)); bfr[j] = *(const GAS bf16x8*)(Wg + 32 * (k0 + j)); }
#pragma unroll
            for (int j = 0; j < 16; ++j) acc = mfma16(af[j], bfr[j], acc);
        }
#pragma unroll
        for (int i = 0; i < 4; ++i) { const int row = r0 + 4 * fq + i; const GAS f32x4* sp = (const GAS f32x4*)(SSQ + (size_t)row * 32); float sacc = 0.f;
#pragma unroll
            for (int q = 0; q < 8; ++q) { const f32x4 v = sp[q]; sacc += (v[0] + v[1]) + (v[2] + v[3]); }
            const float r = rsqrtf(sacc * (1.0f / DM) + EPS);
            P[(size_t)row * INP + C_GG + 16 * ct + fr] = f2bf(acc[i] * r); }
    }
}

__global__ void __launch_bounds__(NTHR, 2) fwd_kernel(Args a) {
    extern __shared__ __attribute__((aligned(16))) unsigned char lds_raw[];
    LAS unsigned char* lds = (LAS unsigned char*)lds_raw;
    cg::grid_group grid = cg::this_grid();
    const int G = gridDim.x;
    if (tidx() < 4) ((LAS unsigned*)(lds + LDS_XB))[tidx()] = 0u;
    __syncthreads();
    XcdBarrier xbar; xbar.bar = (unsigned*)a.ws; xbar.x = 0u; xbar.st = (volatile LAS unsigned*)(lds + LDS_XB);
    for (int ph = a.ph_lo; ph < a.ph_hi; ++ph) {
        unsigned char* ws = a.ws; asm volatile("" : "+s"(ws));
        bf16_t* P = (bf16_t*)(ws + WS_P); bf16_t* XB = (bf16_t*)(ws + WS_XB); float* SSQ = (float*)(ws + WS_SSQ); bf16_t* Y = (bf16_t*)(ws + WS_Y); bf16_t* Hb = (bf16_t*)(ws + WS_H);
        bf16_t* NVT = (bf16_t*)(ws + WS_NVT);
        if (ph == 0) { if (blockIdx.x == 0) for (int i = tidx(); i < XCD_BAR_WORDS; i += NTHR) ((GAS unsigned*)a.ws)[i] = 0u;
                       p0_prologue(a, lds, G); }
        else {
            const int l = (ph - 1) / 7, sub = (ph - 1) % 7;
            if (sub == 0) { if (PHM & 2) {
                if (l == 0) {
                    pg8::Gemm g{(const bf16_t*)(ws + WS_MEMN), (const bf16_t*)(ws + WS_WMEM), 512, 4096, DM}; pg8::StaticOrder S; S.init(512, 4096, G, (int)blockIdx.x);
                    EpiPlain E{(bf16_t*)(ws + WS_MKV), 4096};
                    pg8::gemm_phase<EpiPlain, pg8::StaticOrder, true, true>(lds, g, S, E);
                }
                pg8::Gemm g{XB, (const bf16_t*)(ws + WS_WIN + l * SZ_WIN), MTOK, 5120, DM}; pg8::StaticOrder S; S.init(MTOK, 5120, G, (int)blockIdx.x);
                EpiIn E{P, NVT, SSQ, a.in[9] + l * 64, a.in[10] + l * 64};
                pg8::gemm_phase<EpiIn, pg8::StaticOrder, true, true>(lds, g, S, E);
                gate_gemm(a, l, G); }
            } else if (sub == 1) { if (PHM & 4) {
                if (l == 0) memprep(a, G);
                for (int u = blockIdx.x; u < 2048; u += G) gla_a_unit(a, lds, l, u);
                __syncthreads();
                for (int u = blockIdx.x; u < 1024; u += G) na_attn_block(a, lds, l, u);
                }
            } else if (sub == 2) { if (PHM & 8) {
                gla_scan(a, G);
                for (int u = blockIdx.x; u < 512; u += G) mem_attn_block(a, lds, l, u);
                }
            } else if (sub == 3) {
                if (PHM & 16) for (int u = blockIdx.x; u < 2048; u += G) gla_c_unit(a, lds, l, u);
            } else if (sub == 4) { if (PHM & 32) {
                pg8::Gemm g{Y, (const bf16_t*)(ws + WS_WOUT + l * SZ_WOUT), MTOK, DM, DM}; pg8::StaticOrder S; S.init(MTOK, DM, G, (int)blockIdx.x);
                EpiRes E{l == 0 ? a.in[0] : a.out, a.out, XB, SSQ};
                pg8::gemm_phase<EpiRes, pg8::StaticOrder, true, true>(lds, g, S, E); }
            } else if (sub == 5) { if (PHM & 64) {
                pg8::Gemm g{XB, (const bf16_t*)(ws + WS_W13 + l * SZ_W13), MTOK, 2 * DFF, DM}; pg8::StaticOrder S; S.init(MTOK, 2 * DFF, G, (int)blockIdx.x);
                EpiSwiglu E{Hb, SSQ};
                pg8::gemm_phase<EpiSwiglu, pg8::StaticOrder, true, true>(lds, g, S, E); }
            } else { if (PHM & 128) {
                pg8::Gemm g{Hb, (const bf16_t*)(ws + WS_W2 + l * SZ_W2), MTOK, DM, DFF}; pg8::StaticOrder S; S.init(MTOK, DM, G, (int)blockIdx.x);
                EpiRes E{a.out, a.out, XB, SSQ};
                pg8::gemm_phase<EpiRes, pg8::StaticOrder, true, true>(lds, g, S, E); }
            }
        }
        if (ph + 1 < a.ph_hi) {
            if (ph == a.ph_lo) { asm volatile("s_waitcnt vmcnt(0)" ::: "memory"); grid.sync(); __builtin_amdgcn_fence(__ATOMIC_ACQUIRE, "agent"); asm volatile("s_waitcnt vmcnt(0)" ::: "memory");
                                 xbar = xcd_barrier_post((unsigned*)a.ws, (volatile LAS unsigned*)(lds + LDS_XB)); }
            else xcd_barrier(xbar); }
    }
}

#ifndef MK_MULTI_X
#define MK_MULTI 0
#endif
extern "C" void kernel_launch(void* const* d_in, const int* in_sizes, int n_in, void* d_out, int out_size, void* d_ws, size_t ws_size, hipStream_t stream) {
    static int grid = 0;
    if (grid == 0) {
        int dev = 0, cus = 0, per_cu = 0;
        if (n_in != 22 || out_size != MTOK * DM || ws_size < WS_END) { fprintf(stderr, "kernel_launch: unexpected shapes (n_in %d out %d ws %zu need %zu)\n", n_in, out_size, ws_size, (size_t)WS_END); grid = -1; return; }
        (void)hipGetDevice(&dev);
        (void)hipDeviceGetAttribute(&cus, hipDeviceAttributeMultiprocessorCount, dev);
        (void)hipFuncSetAttribute((const void*)fwd_kernel, hipFuncAttributeMaxDynamicSharedMemorySize, LDS_BYTES);
        (void)hipOccupancyMaxActiveBlocksPerMultiprocessor(&per_cu, (const void*)fwd_kernel, NTHR, LDS_BYTES);
        if (per_cu < 1) per_cu = 1;
        grid = cus * per_cu;
        fprintf(stderr, "kernel_launch: grid %d (cus %d x %d), ws %zu\n", grid, cus, per_cu, ws_size);
    }
    if (grid < 0) return;
    Args a{};
    for (int i = 0; i < 22; ++i) a.in[i] = (const float*)d_in[i];
    a.out = (float*)d_out; a.ws = (unsigned char*)d_ws;
    constexpr int NPH = 1 + 7 * DEPTH;
#if MK_MULTI
    for (int ph = 0; ph < NPH; ++ph) { a.ph_lo = ph; a.ph_hi = ph + 1; hipLaunchKernelGGL(fwd_kernel, dim3(grid), dim3(NTHR), LDS_BYTES, stream, a); }
#else
    a.ph_lo = 0; a.ph_hi = NPH;
    void* args[] = {&a};
    hipError_t e = hipLaunchCooperativeKernel((const void*)fwd_kernel, dim3(grid), dim3(NTHR), args, LDS_BYTES, stream);
    if (e != hipSuccess) fprintf(stderr, "kernel_launch: cooperative launch failed: %s (grid %d)\n", hipGetErrorString(e), grid);
#endif
}
```

```cpp
#include <hip/hip_runtime.h>
#include <hip/hip_cooperative_groups.h>
#include <cstdio>
#include <cstdint>
namespace cg = cooperative_groups;
__device__ __forceinline__ int tidx() { int t = threadIdx.x; asm volatile("" : "+v"(t)); return t; }
namespace pg8 {
#define PG8_LAS __attribute__((address_space(3)))
typedef unsigned short bf16_t;
typedef short bf16x8 __attribute__((ext_vector_type(8)));
typedef float f32x4 __attribute__((ext_vector_type(4)));
typedef unsigned u32x4 __attribute__((ext_vector_type(4)));
constexpr int BM = 256, BK = 64, HALF = 128, HTB = HALF * BK * 2  , STAGE_BYTES = 8 * HTB, NXCD = 8, WGM = 8;

__host__ __device__ __forceinline__ int lds_byte(int r, int c) { const int st = (r >> 4) * 2 + (c >> 5), rr = r & 15, cc = c & 31, ob = rr * 64 + cc * 2; return st * 1024 + (ob ^ (((ob >> 9) & 1) << 5)); }
__host__ __device__ __forceinline__ void stage_rc(int b, int& R, int& C) { const int st = b / 1024, sb = b % 1024, swz = sb ^ (((sb >> 9) & 1) << 5); R = (st >> 1) * 16 + swz / 64; C = (st & 1) * 32 + (swz % 64) / 2; }
__host__ __device__ __forceinline__ int perm32(int rho) { const int n = rho >> 4, i = rho & 15; return 8 * (i >> 2) + 4 * n + (i & 3); }

struct Unit { int pm, pn; };
struct Gemm { const bf16_t* A; const bf16_t* Bt; int M, N, K; };

struct StaticOrder {
    int nM, nN, nwg, G, c;
    __host__ __device__ void init(int M, int N, int G_, int c_) { nM = M / BM; nN = N / BM; nwg = nM * nN; G = G_; c = c_; }
    __host__ __device__ bool next(int i, Unit& u) const {
        const long L = (long)i * G + c; if (L >= nwg) return false;
        int wgid = (int)L; { const int q = nwg / NXCD, r = nwg % NXCD, xcd = wgid % NXCD, off = wgid / NXCD; wgid = (xcd < r ? xcd * (q + 1) : r * (q + 1) + (xcd - r) * q) + off; }
        const int nig = WGM * nN, gid = wgid / nig, fm = gid * WGM, gsz = (nM - fm) < WGM ? (nM - fm) : WGM;
        u.pm = fm + ((wgid % nig) % gsz); u.pn = (wgid % nig) / gsz; return true;
    }
    __device__ __forceinline__ void a_ready(const Unit&) const {}
    __device__ __forceinline__ void done(const Unit&) const {}
};

typedef float f32x2_t __attribute__((ext_vector_type(2))); typedef __bf16 bf16x2_t __attribute__((ext_vector_type(2)));
__device__ __forceinline__ unsigned cvt_pk_bf16(float lo, float hi) { f32x2_t v = {lo, hi}; bf16x2_t b = __builtin_convertvector(v, bf16x2_t); return __builtin_bit_cast(unsigned, b); }
template <class Epi, class Sched, bool ALIGN_EPI = false, bool SP2 = false>
__device__ __forceinline__ void gemm_phase(PG8_LAS unsigned char* lds, const Gemm g, const Sched& S, const Epi& E) {
    const int tid = tidx(), wid = __builtin_amdgcn_readfirstlane(tid >> 6), lane = tid & 63, wr = wid >> 2, wc = wid & 3, fr = lane & 15, fq = lane >> 4;
    const int K = g.K, nt = K / BK;
    unsigned voffA[2], voffB[2];
#pragma unroll
    for (int i = 0; i < 2; ++i) { int R, C; stage_rc(tid * 16 + i * 8192, R, C); const int Rb = Epi::PERM ? ((R & ~31) + perm32(R & 31)) : R;
        voffA[i] = (unsigned)(R * K + C) * 2u; voffB[i] = (unsigned)(Rb * K + C) * 2u; }
    const size_t kstep = (size_t)(BK * 2);
    const size_t hstep = (size_t)HALF * K * 2;
    const size_t tstep = 2 * hstep;
    const unsigned ldsw = (unsigned)wid * 1024u;
    const int aoff = lds_byte(wr * 64 + fr, fq * 8), boff = lds_byte(wc * 32 + fr, fq * 8);
#define PG8_SA(b, h) (((b) * 2 + (h)) * HTB)
#define PG8_SB(b, h) ((4 + (b) * 2 + (h)) * HTB)
#define PG8_STAGE(bufoff, gbase, voff) do { _Pragma("unroll") for (int _i = 0; _i < 2; ++_i) \
        __builtin_amdgcn_global_load_lds((const unsigned*)((const char*)(gbase) + (voff)[_i]), (PG8_LAS unsigned*)(lds + (bufoff) + ldsw + _i * 8192), 16, 0, 0); } while (0)
#define PG8_LDA(dst, b, h) do { _Pragma("unroll") for (int m = 0; m < 4; ++m) _Pragma("unroll") for (int k = 0; k < 2; ++k) dst[m][k] = *(const PG8_LAS bf16x8*)(lds + PG8_SA(b, h) + aoff + m * 2048 + k * 1024); } while (0)
#define PG8_LDB(dst, b, h) do { _Pragma("unroll") for (int n = 0; n < 2; ++n) _Pragma("unroll") for (int k = 0; k < 2; ++k) dst[n][k] = *(const PG8_LAS bf16x8*)(lds + PG8_SB(b, h) + boff + n * 2048 + k * 1024); } while (0)
#define PG8_MMA(ai, bj, At, Bt) do { __builtin_amdgcn_s_setprio(1); _Pragma("unroll") for (int m = 0; m < 4; ++m) _Pragma("unroll") for (int n = 0; n < 2; ++n) _Pragma("unroll") for (int k = 0; k < 2; ++k) \
        acc[ai][bj][m][n] = __builtin_amdgcn_mfma_f32_16x16x32_bf16(Bt[n][k], At[m][k], acc[ai][bj][m][n], 0, 0, 0); __builtin_amdgcn_s_setprio(0); } while (0)
#define PG8_WAIT_V(n) asm volatile("s_waitcnt vmcnt(" #n ")" ::: "memory")
#define PG8_WAIT_L(n) asm volatile("s_waitcnt lgkmcnt(" #n ")" ::: "memory")
#define PG8_BAR __builtin_amdgcn_s_barrier()
#define PG8_SCHED __builtin_amdgcn_sched_barrier(0)
    Unit cur, nxt; int ui = 0;
    if (!S.next(0, cur)) return;
    f32x4 acc[2][2][4][2];
#pragma unroll
    for (int a = 0; a < 2; ++a)
#pragma unroll
        for (int b = 0; b < 2; ++b)
#pragma unroll
            for (int m = 0; m < 4; ++m)
#pragma unroll
                for (int n = 0; n < 2; ++n) acc[a][b][m][n] = (f32x4){0.f, 0.f, 0.f, 0.f};
    bf16x8 At[4][2], B0[2][2], B1[2][2];
    const char* cA = (const char*)g.A + (size_t)cur.pm * tstep; const char* cB = (const char*)g.Bt + (size_t)cur.pn * tstep;
    S.a_ready(cur);
    if constexpr (SP2) {
        PG8_STAGE(PG8_SB(0, 0), cB, voffB); PG8_STAGE(PG8_SB(0, 1), cB + hstep, voffB); PG8_STAGE(PG8_SA(0, 0), cA, voffA); PG8_STAGE(PG8_SA(0, 1), cA + hstep, voffA);
        if (wr == 1) PG8_BAR;
        PG8_WAIT_V(2); PG8_BAR;
        PG8_STAGE(PG8_SB(1, 0), cB + kstep, voffB); PG8_STAGE(PG8_SA(1, 0), cA + kstep, voffA); PG8_STAGE(PG8_SB(1, 1), cB + hstep + kstep, voffB);
        PG8_WAIT_V(6); PG8_BAR;
    } else {
        PG8_STAGE(PG8_SB(0, 0), cB, voffB); PG8_STAGE(PG8_SA(0, 0), cA, voffA); PG8_STAGE(PG8_SB(0, 1), cB + hstep, voffB); PG8_STAGE(PG8_SA(0, 1), cA + hstep, voffA);
        if (wr == 1) PG8_BAR;
        PG8_WAIT_V(4); PG8_BAR;
        PG8_STAGE(PG8_SB(1, 0), cB + kstep, voffB); PG8_STAGE(PG8_SA(1, 0), cA + kstep, voffA); PG8_STAGE(PG8_SB(1, 1), cB + hstep + kstep, voffB);
        PG8_WAIT_V(6); PG8_BAR;
    }
    for (;;) {
        const bool has_next = S.next(ui + 1, nxt);
        const char* nA = has_next ? (const char*)g.A + (size_t)nxt.pm * tstep : cA; const char* nB = has_next ? (const char*)g.Bt + (size_t)nxt.pn * tstep : cB;
        for (int t = 0; t < nt; t += 2) {
            const bool last = (t == nt - 2);
            const char* a1 = cA + (size_t)(t + 1) * kstep;
            const char* a2 = last ? nA : cA + (size_t)(t + 2) * kstep; const char* b2 = last ? nB : cB + (size_t)(t + 2) * kstep;
            const char* a3 = a2 + kstep; const char* b3 = b2 + kstep;
            if (last && has_next) S.a_ready(nxt);
            if constexpr (SP2) {
            PG8_LDB(B0, 0, 0); PG8_LDB(B1, 0, 1); PG8_SCHED; PG8_LDA(At, 0, 0); PG8_STAGE(PG8_SA(1, 1), a1 + hstep, voffA);
            PG8_WAIT_V(8); PG8_WAIT_L(0); PG8_BAR; PG8_MMA(0, 0, At, B0); PG8_MMA(0, 1, At, B1); PG8_BAR; PG8_SCHED;
            PG8_LDA(At, 0, 1); PG8_STAGE(PG8_SB(0, 0), b2, voffB); PG8_STAGE(PG8_SB(0, 1), b2 + hstep, voffB); PG8_STAGE(PG8_SA(0, 0), a2, voffA);
            PG8_WAIT_V(8); PG8_WAIT_L(0); PG8_BAR; PG8_MMA(1, 0, At, B0); PG8_MMA(1, 1, At, B1); PG8_BAR; PG8_SCHED;
            PG8_LDB(B0, 1, 0); PG8_LDB(B1, 1, 1); PG8_SCHED; PG8_LDA(At, 1, 0); PG8_STAGE(PG8_SA(0, 1), a2 + hstep, voffA);
            PG8_WAIT_V(8); PG8_WAIT_L(0); PG8_BAR; PG8_MMA(0, 0, At, B0); PG8_MMA(0, 1, At, B1); PG8_BAR; PG8_SCHED;
            PG8_LDA(At, 1, 1); PG8_STAGE(PG8_SB(1, 0), b3, voffB); PG8_STAGE(PG8_SB(1, 1), b3 + hstep, voffB); PG8_STAGE(PG8_SA(1, 0), a3, voffA);
            PG8_WAIT_V(8); PG8_WAIT_L(0); PG8_BAR; PG8_MMA(1, 0, At, B0); PG8_MMA(1, 1, At, B1); PG8_BAR; PG8_SCHED;
            } else {
            PG8_LDB(B0, 0, 0); PG8_SCHED; PG8_LDA(At, 0, 0); PG8_STAGE(PG8_SA(1, 1), a1 + hstep, voffA);
            PG8_WAIT_L(8); PG8_BAR; PG8_WAIT_L(0); PG8_MMA(0, 0, At, B0); PG8_BAR; PG8_SCHED;
            PG8_LDB(B1, 0, 1); PG8_STAGE(PG8_SB(0, 0), b2, voffB);
            PG8_BAR; PG8_WAIT_L(0); PG8_MMA(0, 1, At, B1); PG8_BAR;
            PG8_LDA(At, 0, 1); PG8_STAGE(PG8_SA(0, 0), a2, voffA);
            PG8_BAR; PG8_WAIT_L(0); PG8_MMA(1, 0, At, B0); PG8_BAR; PG8_SCHED;
            PG8_STAGE(PG8_SB(0, 1), b2 + hstep, voffB);
            PG8_WAIT_V(6); PG8_BAR; PG8_MMA(1, 1, At, B1); PG8_BAR;
            PG8_LDB(B0, 1, 0); PG8_SCHED; PG8_LDA(At, 1, 0); PG8_STAGE(PG8_SA(0, 1), a2 + hstep, voffA);
            PG8_WAIT_L(8); PG8_BAR; PG8_WAIT_L(0); PG8_MMA(0, 0, At, B0); PG8_BAR; PG8_SCHED;
            PG8_LDB(B1, 1, 1); PG8_STAGE(PG8_SB(1, 0), b3, voffB);
            PG8_BAR; PG8_WAIT_L(0); PG8_MMA(0, 1, At, B1); PG8_BAR;
            PG8_LDA(At, 1, 1); PG8_STAGE(PG8_SA(1, 0), a3, voffA);
            PG8_BAR; PG8_WAIT_L(0); PG8_MMA(1, 0, At, B0); PG8_BAR; PG8_SCHED;
            PG8_STAGE(PG8_SB(1, 1), b3 + hstep, voffB);
            PG8_WAIT_V(6); PG8_BAR; PG8_MMA(1, 1, At, B1); PG8_BAR;
            }
        }
        if constexpr (ALIGN_EPI) { if (wr == 0) PG8_BAR; }
        if constexpr (!Epi::AFTER_DRAIN) { E(acc, cur, wr, wc, fr, fq); S.done(cur); }
        if (!has_next) break;
#pragma unroll
        for (int a = 0; a < 2; ++a)
#pragma unroll
            for (int b = 0; b < 2; ++b)
#pragma unroll
                for (int m = 0; m < 4; ++m)
#pragma unroll
                    for (int n = 0; n < 2; ++n) acc[a][b][m][n] = (f32x4){0.f, 0.f, 0.f, 0.f};
        cur = nxt; cA = nA; cB = nB; ++ui;
        if constexpr (ALIGN_EPI) { if (wr == 1) PG8_BAR; }
    }
    PG8_WAIT_V(0);
    if constexpr (!ALIGN_EPI) { if (wr == 0) PG8_BAR; }
    PG8_BAR;
    if constexpr (Epi::AFTER_DRAIN) { E.fused(acc, cur, wr, wc, fr, fq, lds, wid, lane); S.done(cur); }
#undef PG8_SA
#undef PG8_SB
#undef PG8_STAGE
#undef PG8_LDA
#undef PG8_LDB
#undef PG8_MMA
#undef PG8_WAIT_V
#undef PG8_WAIT_L
#undef PG8_BAR
#undef PG8_SCHED
}
}

#define LAS __attribute__((address_space(3)))
#define GAS __attribute__((address_space(1)))
#define XB_TMO      128
#define XB_XCNT(j)  (256  + 64 * (j))
#define XB_XSUB(j)  (1280 + 64 * (j))
#define XB_XGEN(j)  (2304 + 64 * (j))
#define XB_TOP      3328
#define XB_TOPGEN   3392
#define XCD_BAR_WORDS 3456
#define XB_SPIN_CAP (1u << 18)

__device__ __forceinline__ unsigned xb_ld(unsigned* p)              { return __hip_atomic_load(p, __ATOMIC_RELAXED, __HIP_MEMORY_SCOPE_AGENT); }
__device__ __forceinline__ unsigned xb_add(unsigned* p, unsigned v) { return __hip_atomic_fetch_add(p, v, __ATOMIC_RELAXED, __HIP_MEMORY_SCOPE_AGENT); }
__device__ __forceinline__ unsigned xb_xcc_id() { return (unsigned)__builtin_amdgcn_s_getreg((3 << 11) | 20) & 0xFu; }
#define XB_SPIN(cond, bar) do { unsigned _sp = 0; while (cond) { __builtin_amdgcn_s_sleep(1); \
    if ((++_sp & 255u) == 0u) { if (xb_ld(&(bar)[XB_TMO])) break; if (_sp > XB_SPIN_CAP) { atomicAdd(&(bar)[XB_TMO], 1u); break; } } } } while (0)

struct XcdBarrier {
    unsigned* bar; unsigned x;
    volatile LAS unsigned* st;
};

__device__ __forceinline__ XcdBarrier xcd_barrier_post(unsigned* bar, volatile LAS unsigned* st) {
    XcdBarrier b; b.bar = bar; b.x = xb_xcc_id(); b.st = st;
    if (threadIdx.x == 0) (void)xb_add(&bar[XB_XCNT(b.x)], 1u);
    return b;
}
__device__ __forceinline__ void xcd_barrier_complete(unsigned* bar, unsigned x, unsigned& nloc, unsigned& nx) {
    const unsigned G = gridDim.x * gridDim.y * gridDim.z;
    unsigned sum, cnt, mine, sp = 0u;
    for (;;) {
        sum = 0u; cnt = 0u; mine = 0u;
#pragma unroll
        for (unsigned j = 0; j < 16; ++j) { const unsigned c = xb_ld(&bar[XB_XCNT(j)]); sum += c; cnt += (c > 0u) ? 1u : 0u; mine = (j == x) ? c : mine; }
        if (sum == G) break;
        __builtin_amdgcn_s_sleep(1);
        if ((++sp & 255u) == 0u) { if (xb_ld(&bar[XB_TMO])) break; if (sp > XB_SPIN_CAP) { atomicAdd(&bar[XB_TMO], 1u); break; } }
    }
    nloc = mine > 0u ? mine : 1u; nx = cnt > 0u ? cnt : 1u;
}

__device__ __forceinline__ void xcd_barrier(const XcdBarrier& b) {
    asm volatile("s_waitcnt vmcnt(0)" ::: "memory");
    __syncthreads();
    if (threadIdx.x == 0) {
        unsigned* bar = b.bar;
        __builtin_amdgcn_s_waitcnt(0);
        unsigned nloc = b.st[0], nx = b.st[1];
        if (nloc == 0u) { xcd_barrier_complete(bar, b.x, nloc, nx); b.st[0] = nloc; b.st[1] = nx; }
        const unsigned old = xb_add(&bar[XB_XSUB(b.x)], 1u);
        const unsigned gen = old / nloc;
        if (old + 1u == (gen + 1u) * nloc) {
            __builtin_amdgcn_fence(__ATOMIC_RELEASE, "agent");
            asm volatile("s_waitcnt vmcnt(0)" ::: "memory");
            const unsigned og = xb_add(&bar[XB_TOP], 1u);
            const unsigned tg = og / nx;
            if (og + 1u == (tg + 1u) * nx) xb_add(&bar[XB_TOPGEN], 1u);
            else XB_SPIN(xb_ld(&bar[XB_TOPGEN]) == tg, bar);
            __builtin_amdgcn_fence(__ATOMIC_ACQUIRE, "agent");
            xb_add(&bar[XB_XGEN(b.x)], 1u);
            asm volatile("s_waitcnt vmcnt(0)" ::: "memory");
        } else {
            XB_SPIN(xb_ld(&bar[XB_XGEN(b.x)]) == gen, bar);
            __builtin_amdgcn_fence(__ATOMIC_ACQUIRE, "agent");
            asm volatile("s_waitcnt vmcnt(0)" ::: "memory");
        }
    }
    __syncthreads();
}

using pg8::bf16_t; using pg8::bf16x8; using pg8::f32x4; using pg8::Unit; using pg8::cvt_pk_bf16;
typedef unsigned u32x2 __attribute__((ext_vector_type(2)));
typedef unsigned u32x4 __attribute__((ext_vector_type(4)));
typedef float f32x2 __attribute__((ext_vector_type(2)));

constexpr int DM = 2048, BATCH = 2, SEQ = 8192, DEPTH = 4, MTOK = BATCH * SEQ;
constexpr int INC = 5152, INP = 5376, DFF = 5632, MEMT = 256;
constexpr int C_GQ = 0, C_GK = 512, C_GV = 1024, C_GR = 2048, C_NQ = 3072, C_NK = 3584, C_NV = 4096, C_MQ = 4608, C_GG = 5120;
constexpr float EPS = 1e-6f;
constexpr int NTHR = 512, NWAVES = 8;

constexpr size_t MiB = 1u << 20;
constexpr size_t WS_WG2T = 65536;
constexpr size_t WS_WIN = 1 * MiB, SZ_WIN = (size_t)INP * DM * 2;
constexpr size_t WS_WOUT = WS_WIN + 4 * SZ_WIN, SZ_WOUT = (size_t)DM * DM * 2;
constexpr size_t WS_W13 = WS_WOUT + 4 * SZ_WOUT, SZ_W13 = (size_t)2 * DFF * DM * 2;
constexpr size_t WS_W2 = WS_W13 + 4 * SZ_W13, SZ_W2 = (size_t)DM * DFF * 2;
constexpr size_t WS_WMEM = WS_W2 + 4 * SZ_W2;
constexpr size_t WS_XB = WS_WMEM + (size_t)4096 * DM * 2;
constexpr size_t WS_SSQ = WS_XB + (size_t)MTOK * DM * 2;
constexpr size_t WS_P = WS_SSQ + (size_t)MTOK * 32 * 4;
constexpr size_t WS_NVT = WS_P + (size_t)MTOK * INP * 2;
constexpr size_t WS_Y = WS_NVT + (size_t)MTOK * 512 * 2;
constexpr size_t WS_ST = WS_Y + (size_t)MTOK * DM * 2;
constexpr size_t WS_DEC = WS_ST + (size_t)2048 * 2 * 32768 * 2;
constexpr size_t WS_MEMN = WS_DEC + (size_t)2048 * 2 * 128 * 4;
constexpr size_t WS_MKV = WS_MEMN + (size_t)512 * DM * 2;
constexpr size_t WS_KM = WS_MKV + (size_t)512 * 4096 * 2;
constexpr size_t WS_VMT = WS_KM + (size_t)32 * 256 * 128 * 2;
constexpr size_t WS_H = WS_VMT + (size_t)32 * 256 * 128 * 2;
constexpr size_t WS_ST2 = WS_H;
constexpr size_t WS_CUMG = WS_ST2 + (size_t)2048 * 2 * 32768 * 2;
constexpr size_t WS_END = WS_CUMG + (size_t)2 * MTOK * 512 * 4;

constexpr int LDS_BYTES = 147456 + 4096;
constexpr int LDS_XB = 147456 + 3584;
#ifndef PHM
#define PHM 255
#endif

__device__ __forceinline__ float bflo(unsigned w) { return __uint_as_float(w << 16); }
__device__ __forceinline__ float bfhi(unsigned w) { return __uint_as_float(w & 0xffff0000u); }
__device__ __forceinline__ float bf2f(unsigned short b) { return __uint_as_float((unsigned)b << 16); }
__device__ __forceinline__ unsigned short f2bf(float f) { return (unsigned short)(cvt_pk_bf16(f, 0.f) & 0xffffu); }
__device__ __forceinline__ float wave_sum(float v) {
#pragma unroll
    for (int o = 1; o < 64; o <<= 1) v += __shfl_xor(v, o);
    return v;
}
__device__ __forceinline__ float fq_sum(float v) { v += __shfl_xor(v, 16); v += __shfl_xor(v, 32); return v; }
__device__ __forceinline__ float fq_max(float v) { v = fmaxf(v, __shfl_xor(v, 16)); v = fmaxf(v, __shfl_xor(v, 32)); return v; }
__device__ __forceinline__ float fr_sum(float v) { v += __shfl_xor(v, 1); v += __shfl_xor(v, 2); v += __shfl_xor(v, 4); v += __shfl_xor(v, 8); return v; }
__device__ __forceinline__ float dot4(f32x4 a) { return (a[0] * a[0] + a[1] * a[1]) + (a[2] * a[2] + a[3] * a[3]); }
__device__ __forceinline__ u32x2 pk4(f32x4 v) { u32x2 w; w.x = cvt_pk_bf16(v[0], v[1]); w.y = cvt_pk_bf16(v[2], v[3]); return w; }
__device__ __forceinline__ bf16x8 pk8(f32x4 a, f32x4 b) { u32x4 w; w.x = cvt_pk_bf16(a[0], a[1]); w.y = cvt_pk_bf16(a[2], a[3]); w.z = cvt_pk_bf16(b[0], b[1]); w.w = cvt_pk_bf16(b[2], b[3]); return __builtin_bit_cast(bf16x8, w); }
__device__ __forceinline__ f32x4 mfma16(bf16x8 a, bf16x8 b, f32x4 c) { return __builtin_amdgcn_mfma_f32_16x16x32_bf16(a, b, c, 0, 0, 0); }

__device__ __forceinline__ void row_rstd(const float* ssq, int rowb, int fq, float (&rs)[2][4]) {
#pragma unroll
    for (int ai = 0; ai < 2; ++ai)
#pragma unroll
        for (int m = 0; m < 4; ++m) {
            const f32x4* sp = (const f32x4*)(ssq + (size_t)(rowb + ai * 128 + m * 16) * 32 + fq * 8);
            const f32x4 a = sp[0], b = sp[1];
            float s = ((a[0] + a[1]) + (a[2] + a[3])) + ((b[0] + b[1]) + (b[2] + b[3]));
            s = fq_sum(s);
            rs[ai][m] = rsqrtf(s * (1.0f / DM) + EPS);
        }
}

__device__ __forceinline__ void row_rstd_cached(const float* ssq, LAS float* slot, int pm, int rowb, int fq, float (&rs)[2][4]) {
    if (__float_as_int(slot[8]) == pm) {
#pragma unroll
        for (int i = 0; i < 8; ++i) rs[i >> 2][i & 3] = slot[i];
    } else {
        row_rstd(ssq, rowb, fq, rs);
#pragma unroll
        for (int i = 0; i < 8; ++i) slot[i] = rs[i >> 2][i & 3];
        slot[8] = __int_as_float(pm);
    }
}

struct EpiIn {
    static constexpr bool PERM = false, AFTER_DRAIN = false;
    bf16_t* P; bf16_t* NVT; const float* ssq; const float* gq; const float* gk; LAS float* slot;
    __device__ __forceinline__ void operator()(const f32x4 (&acc)[2][2][4][2], const Unit& u, int wr, int wc, int fr, int fq) const {
        const int rowb = u.pm * 256 + wr * 64 + fr, pn = u.pn;
        float rs[2][4]; row_rstd_cached(ssq, slot, u.pm, rowb, fq, rs);
        if (pn >= 12 && pn < 16) {
            const float* g = pn < 14 ? gq : gk; const float sc = pn < 14 ? 0.125f : 1.0f;
            f32x4 gv[2][2];
#pragma unroll
            for (int bj = 0; bj < 2; ++bj)
#pragma unroll
                for (int n = 0; n < 2; ++n) gv[bj][n] = *(const f32x4*)(g + 32 * bj + 16 * n + 4 * fq) * sc;
#pragma unroll
            for (int ai = 0; ai < 2; ++ai)
#pragma unroll
                for (int m = 0; m < 4; ++m) {
                    const float r = rs[ai][m]; float q = 0.f; f32x4 v[2][2];
#pragma unroll
                    for (int bj = 0; bj < 2; ++bj)
#pragma unroll
                        for (int n = 0; n < 2; ++n) { v[bj][n] = acc[ai][bj][m][n] * r; q += dot4(v[bj][n]); }
                    q = fq_sum(q);
                    const float hr = rsqrtf(q * (1.0f / 64.0f) + EPS);
                    bf16_t* rowp = P + (size_t)(rowb + ai * 128 + m * 16) * INP + pn * 256 + 64 * wc + 4 * fq;
#pragma unroll
                    for (int bj = 0; bj < 2; ++bj)
#pragma unroll
                        for (int n = 0; n < 2; ++n) *(u32x2*)(rowp + 32 * bj + 16 * n) = pk4(v[bj][n] * hr * gv[bj][n]);
                    asm volatile("" ::: "memory");
                }
        } else if (pn == 16 || pn == 17) {
#pragma unroll
            for (int ai = 0; ai < 2; ++ai)
#pragma unroll
                for (int m = 0; m < 4; ++m) {
                    const int row = rowb + ai * 128 + m * 16, b = row >> 13, tok = row & 8191; const float r = rs[ai][m];
#pragma unroll
                    for (int bj = 0; bj < 2; ++bj)
#pragma unroll
                        for (int n = 0; n < 2; ++n) {
                            const int c = (pn - 16) * 256 + bj * 128 + wc * 32 + n * 16 + 4 * fq;
                            bf16_t* p = NVT + ((size_t)(b * 512 + c)) * 8192 + tok;
                            const f32x4 v = acc[ai][bj][m][n] * r;
                            p[0] = f2bf(v[0]); p[8192] = f2bf(v[1]); p[2 * 8192] = f2bf(v[2]); p[3 * 8192] = f2bf(v[3]);
                            asm volatile("" ::: "memory");
                        }
                }
        } else {
            const float sc = pn < 2 ? 0.08838834764831845f : 1.0f;
#pragma unroll
            for (int ai = 0; ai < 2; ++ai)
#pragma unroll
                for (int m = 0; m < 4; ++m) {
                    const float r = rs[ai][m] * sc;
                    bf16_t* rowp = P + (size_t)(rowb + ai * 128 + m * 16) * INP + pn * 256 + wc * 32 + 4 * fq;
#pragma unroll
                    for (int bj = 0; bj < 2; ++bj)
#pragma unroll
                        for (int n = 0; n < 2; ++n) *(u32x2*)(rowp + bj * 128 + n * 16) = pk4(acc[ai][bj][m][n] * r);
                    asm volatile("" ::: "memory");
                }
        }
    }
};

struct EpiRes {
    static constexpr bool PERM = false, AFTER_DRAIN = false;
    const float* xin; float* xout; bf16_t* XB; float* ssq;
    __device__ __forceinline__ void operator()(const f32x4 (&acc)[2][2][4][2], const Unit& u, int wr, int wc, int fr, int fq) const {
        const int rowb = u.pm * 256 + wr * 64 + fr, colb = u.pn * 256 + wc * 32 + 4 * fq;
#pragma unroll
        for (int ai = 0; ai < 2; ++ai) {
            f32x4 xr[4][2][2];
#pragma unroll
            for (int m = 0; m < 4; ++m)
#pragma unroll
                for (int bj = 0; bj < 2; ++bj)
#pragma unroll
                    for (int n = 0; n < 2; ++n) xr[m][bj][n] = *(const GAS f32x4*)((const GAS float*)xin + (size_t)(rowb + ai * 128 + m * 16) * DM + colb + bj * 128 + n * 16);
#pragma unroll
            for (int m = 0; m < 4; ++m) {
                const int row = rowb + ai * 128 + m * 16; float q = 0.f;
#pragma unroll
                for (int bj = 0; bj < 2; ++bj)
#pragma unroll
                    for (int n = 0; n < 2; ++n) {
                        const size_t off = (size_t)row * DM + colb + bj * 128 + n * 16;
                        const f32x4 x = xr[m][bj][n] + acc[ai][bj][m][n];
                        *(GAS f32x4*)((GAS float*)xout + off) = x; *(GAS u32x2*)((GAS bf16_t*)XB + off) = pk4(x); q += dot4(x);
                    }
                q = fq_sum(q);
                if (fq == 0) ssq[(size_t)row * 32 + u.pn * 4 + wc] = q;
            }
            asm volatile("" ::: "memory");
        }
    }
};

struct EpiSwiglu {
    static constexpr bool PERM = false, AFTER_DRAIN = false;
    bf16_t* H; const float* ssq; LAS float* slot;
    __device__ __forceinline__ void operator()(const f32x4 (&acc)[2][2][4][2], const Unit& u, int wr, int wc, int fr, int fq) const {
        const int rowb = u.pm * 256 + wr * 64 + fr;
        float rs[2][4]; row_rstd_cached(ssq, slot, u.pm, rowb, fq, rs);
#pragma unroll
        for (int ai = 0; ai < 2; ++ai)
#pragma unroll
            for (int m = 0; m < 4; ++m) {
                const float r = rs[ai][m];
                bf16_t* rowp = H + (size_t)(rowb + ai * 128 + m * 16) * DFF + u.pn * 128 + wc * 32 + 4 * fq;
#pragma unroll
                for (int n = 0; n < 2; ++n) {
                    const f32x4 g = acc[ai][0][m][n] * r, up = acc[ai][1][m][n] * r; f32x4 h;
#pragma unroll
                    for (int e = 0; e < 4; ++e) h[e] = g[e] * __builtin_amdgcn_rcpf(1.0f + __expf(-g[e])) * up[e];
                    *(u32x2*)(rowp + n * 16) = pk4(h);
                }
            }
    }
};

struct EpiPlain {
    static constexpr bool PERM = false, AFTER_DRAIN = false;
    bf16_t* O; int ldc;
    __device__ __forceinline__ void operator()(const f32x4 (&acc)[2][2][4][2], const Unit& u, int wr, int wc, int fr, int fq) const {
        const int rowb = u.pm * 256 + wr * 64 + fr;
#pragma unroll
        for (int ai = 0; ai < 2; ++ai)
#pragma unroll
            for (int m = 0; m < 4; ++m) {
                bf16_t* rowp = O + (size_t)(rowb + ai * 128 + m * 16) * ldc + u.pn * 256 + wc * 32 + 4 * fq;
#pragma unroll
                for (int bj = 0; bj < 2; ++bj)
#pragma unroll
                    for (int n = 0; n < 2; ++n) *(u32x2*)(rowp + bj * 128 + n * 16) = pk4(acc[ai][bj][m][n]);
            }
    }
};

__device__ __forceinline__ int in_map(int c) {
    if (c < 3072) return c;
    if (c < 4096) { const int cc = c - 3072, t = cc >> 8, cl = cc & 255, bj = cl >> 7, wc = (cl >> 5) & 3; return 3104 + 256 * t + 64 * wc + 32 * bj; }
    if (c < 5120) return c + 32;
    if (c == 5120) return 3072;
    return -1;
}
__device__ __forceinline__ int w13_map(int c) { const int t = c >> 8, cl = c & 255; return cl < 128 ? 128 * t + cl : DFF + 128 * t + (cl - 128); }

__device__ __forceinline__ void tr_item(const float* W, int ldw, int sc, const float* gain, bf16_t* WT, int K, int drow0, int k0, LAS float* scr, int lane) {
    if (sc < 0) {
        const int c = lane & 7;
#pragma unroll
        for (int j = 0; j < 4; ++j) { const int n = (lane >> 3) + 8 * j; *(u32x4*)(WT + (size_t)(drow0 + n) * K + k0 + 8 * c) = (u32x4){0u, 0u, 0u, 0u}; }
        return;
    }
    { const GAS float* wp = (const GAS float*)W + (size_t)(k0 + (lane >> 5)) * ldw + sc + (lane & 31); float w[32];
#pragma unroll
      for (int i = 0; i < 32; ++i) w[i] = wp[(size_t)(2 * i) * ldw];
      if (gain) { const GAS float* gp = (const GAS float*)gain + k0 + (lane >> 5);
#pragma unroll
          for (int i = 0; i < 32; ++i) w[i] *= gp[2 * i]; }
#pragma unroll
      for (int i = 0; i < 32; ++i) scr[(2 * i + (lane >> 5)) * 33 + (lane & 31)] = w[i]; }
    asm volatile("s_waitcnt lgkmcnt(0)" ::: "memory");
    const int c = lane & 7;
#pragma unroll
    for (int j = 0; j < 4; ++j) { const int n = (lane >> 3) + 8 * j; const LAS float* s = scr + (8 * c) * 33 + n;
        u32x4 o; o.x = cvt_pk_bf16(s[0 * 33], s[1 * 33]); o.y = cvt_pk_bf16(s[2 * 33], s[3 * 33]); o.z = cvt_pk_bf16(s[4 * 33], s[5 * 33]); o.w = cvt_pk_bf16(s[6 * 33], s[7 * 33]);
        *(u32x4*)(WT + (size_t)(drow0 + n) * K + k0 + 8 * c) = o; }
    asm volatile("s_waitcnt lgkmcnt(0)" ::: "memory");
}

struct Args { const float* in[22]; float* out; unsigned char* ws; int ph_lo, ph_hi; };

__device__ __forceinline__ void p0_prologue(const Args& a, LAS unsigned char* lds, int G) {
    const int tid = tidx(), lane = tid & 63, wave = tid >> 6;
    LAS float* scr = (LAS float*)(lds + wave * 16384);
    const int gw = blockIdx.x * NWAVES + wave, NGW = G * NWAVES;
    constexpr int I_IN = 32 * (INP / 32), I_OUT = 32 * 64, I_13 = 32 * (2 * DFF / 32), I_2 = (DFF / 64) * 64, I_MEM = 32 * 32, I_L = I_IN + I_OUT + I_13 + I_2 + I_MEM;
    unsigned char* ws = a.ws;
    for (int it = gw; it < DEPTH * I_L; it += NGW) {
        const int l = it / I_L; int r = it % I_L;
        if (r < I_IN) { const int nb = r % (INP / 32), kb = r / (INP / 32);
            tr_item(a.in[3] + (size_t)l * DM * INC, INC, in_map(nb * 32), a.in[2] + l * DM, (bf16_t*)(ws + WS_WIN + l * SZ_WIN), DM, nb * 32, kb * 64, scr, lane); continue; }
        r -= I_IN;
        if (r < I_OUT) { const int nb = r % 64, kb = r / 64;
            tr_item(a.in[18] + (size_t)l * DM * DM, DM, nb * 32, nullptr, (bf16_t*)(ws + WS_WOUT + l * SZ_WOUT), DM, nb * 32, kb * 64, scr, lane); continue; }
        r -= I_OUT;
        if (r < I_13) { const int nb = r % (2 * DFF / 32), kb = r / (2 * DFF / 32);
            tr_item(a.in[20] + (size_t)l * DM * 2 * DFF, 2 * DFF, w13_map(nb * 32), a.in[19] + l * DM, (bf16_t*)(ws + WS_W13 + l * SZ_W13), DM, nb * 32, kb * 64, scr, lane); continue; }
        r -= I_13;
        if (r < I_2) { const int nb = r % 64, kb = r / 64;
            tr_item(a.in[21] + (size_t)l * DFF * DM, DM, nb * 32, nullptr, (bf16_t*)(ws + WS_W2 + l * SZ_W2), DFF, nb * 32, kb * 64, scr, lane); continue; }
        r -= I_2;
        { const int nb = r % 32, kb = r / 32;
            tr_item(a.in[14] + (size_t)l * DM * 1024, 1024, nb * 32, a.in[13] + l * DM, (bf16_t*)(ws + WS_WMEM), DM, l * 1024 + nb * 32, kb * 64, scr, lane); }
    }
    for (int idx = gw * 64 + lane; idx < DEPTH * 2 * 512; idx += NGW * 64) {
        const int dd = idx & 511, dir = (idx >> 9) & 1, ll = idx >> 10;
        const GAS float* src = (const GAS float*)a.in[dir ? 6 : 4] + (size_t)ll * 16 * 512 + dd;
        u32x4 w0, w1;
        w0.x = cvt_pk_bf16(src[0 * 512], src[1 * 512]); w0.y = cvt_pk_bf16(src[2 * 512], src[3 * 512]); w0.z = cvt_pk_bf16(src[4 * 512], src[5 * 512]); w0.w = cvt_pk_bf16(src[6 * 512], src[7 * 512]);
        w1.x = cvt_pk_bf16(src[8 * 512], src[9 * 512]); w1.y = cvt_pk_bf16(src[10 * 512], src[11 * 512]); w1.z = cvt_pk_bf16(src[12 * 512], src[13 * 512]); w1.w = cvt_pk_bf16(src[14 * 512], src[15 * 512]);
        GAS u32x4* dst = (GAS u32x4*)(ws + WS_WG2T + (size_t)idx * 64);
        dst[0] = w0; dst[1] = w1; dst[2] = (u32x4){0u, 0u, 0u, 0u}; dst[3] = (u32x4){0u, 0u, 0u, 0u};
    }
    bf16_t* XB = (bf16_t*)(ws + WS_XB); float* SSQ = (float*)(ws + WS_SSQ); bf16_t* MEMN = (bf16_t*)(ws + WS_MEMN);
    for (int row = gw; row < MTOK + BATCH * MEMT; row += NGW) {
        const bool isx = row < MTOK; const int rr = isx ? row : row - MTOK;
        const f32x4* xr = (const f32x4*)((isx ? a.in[0] : a.in[1]) + (size_t)rr * DM) + lane;
        f32x4 v[8]; float s = 0.f;
#pragma unroll
        for (int j = 0; j < 8; ++j) { v[j] = xr[64 * j]; s += dot4(v[j]); }
        s = wave_sum(s);
        float sc = 1.0f;
        if (isx) { if (lane < 32) SSQ[(size_t)rr * 32 + lane] = lane == 0 ? s : 0.f; }
        else sc = rsqrtf(s * (1.0f / DM) + EPS);
        u32x2* o = (u32x2*)((isx ? XB : MEMN) + (size_t)rr * DM) + lane;
#pragma unroll
        for (int j = 0; j < 8; ++j) o[64 * j] = pk4(v[j] * sc);
    }
}

__device__ __forceinline__ void memprep(const Args& a, int G) {
    const int lane = tidx() & 63, wave = tidx() >> 6;
    const int gw = blockIdx.x * NWAVES + wave, NGW = G * NWAVES;
    const bf16_t* MKV = (const bf16_t*)(a.ws + WS_MKV); bf16_t* KM = (bf16_t*)(a.ws + WS_KM); bf16_t* VMT = (bf16_t*)(a.ws + WS_VMT);
    for (int it = gw; it < DEPTH * BATCH * 4 * MEMT; it += NGW) {
        const int key = it & 255, h = (it >> 8) & 3, b = (it >> 10) & 1, l = it >> 11;
        const bf16_t* src = MKV + (size_t)(b * 256 + key) * 4096 + l * 1024 + h * 128 + 2 * lane;
        const unsigned kw = *(const unsigned*)src, vw = *(const unsigned*)(src + 512);
        const float k0 = bflo(kw), k1 = bfhi(kw);
        const float ss = wave_sum(k0 * k0 + k1 * k1);
        const float r = rsqrtf(ss * (1.0f / 128.0f) + EPS) * 0.08838834764831845f;
        const float* gk = a.in[16] + l * 128 + 2 * lane; const float* gq = a.in[15] + l * 128 + 2 * lane;
        const size_t hb = (size_t)((l * 2 + b) * 4 + h) * 32768;
        *(unsigned*)(KM + hb + key * 128 + 2 * lane) = cvt_pk_bf16(k0 * r * gk[0] * gq[0], k1 * r * gk[1] * gq[1]);
        VMT[hb + (size_t)(2 * lane) * 256 + key] = (bf16_t)(vw & 0xffffu);
        VMT[hb + (size_t)(2 * lane + 1) * 256 + key] = (bf16_t)(vw >> 16);
    }
}

template <int D, bool IS_NA>
__device__ __forceinline__ void attn16(const bf16_t* qrow, const bf16_t* kbase, long kstride, int key0, int krstep,
                                       const bf16_t* vtbase, long vtstride, int vkey0,
                                       const LAS float* rpbh, int r, int rs, int j, int kc0,
                                       const float* ogain, bf16_t* y0, int fr, int fq) {
    bf16x8 qf[D / 32];
#pragma unroll
    for (int ks = 0; ks < D / 32; ++ks) qf[ks] = *(const GAS bf16x8*)((const GAS bf16_t*)qrow + 32 * ks + 8 * fq);
    float qscale = 1.0f;
    if (!IS_NA) {
        float ss = 0.f;
#pragma unroll
        for (int ks = 0; ks < D / 32; ++ks) { const u32x4 w = __builtin_bit_cast(u32x4, qf[ks]);
#pragma unroll
            for (int e = 0; e < 4; ++e) { const float lo = bflo(w[e]), hi = bfhi(w[e]); ss += lo * lo + hi * hi; } }
        ss = fq_sum(ss);
        qscale = rsqrtf(ss * (1.0f / D) + EPS);
    }
    f32x4 s[16];
    const int kro = 8 * (fr >> 2) + (fr & 3);
    constexpr int NK = D / 32, GT = 8 / NK;
    const GAS bf16_t* kb0 = (const GAS bf16_t*)kbase + (long)(key0 + kro) * kstride + 8 * fq;
    bf16x8 kf[2][GT][NK];
#define ATT_LDK(buf, g) do { _Pragma("unroll") for (int tt_ = 0; tt_ < GT; ++tt_) { const int t_ = (g) * GT + tt_, kr_ = t_ >> 1, u_ = t_ & 1; \
        const GAS bf16_t* kp_ = kb0 + (long)(kr_ * krstep + 4 * u_) * kstride; \
        _Pragma("unroll") for (int ks_ = 0; ks_ < NK; ++ks_) kf[buf][tt_][ks_] = *(const GAS bf16x8*)(kp_ + 32 * ks_); } } while (0)
    ATT_LDK(0, 0);
#pragma unroll
    for (int g = 0; g < 16 / GT; ++g) {
        if (g + 1 < 16 / GT) ATT_LDK((g + 1) & 1, g + 1);
#pragma unroll
        for (int tt = 0; tt < GT; ++tt) { f32x4 acc = (f32x4){0.f, 0.f, 0.f, 0.f};
#pragma unroll
            for (int ks = 0; ks < NK; ++ks) acc = mfma16(kf[g & 1][tt][ks], qf[ks], acc);
            s[g * GT + tt] = acc; }
    }
#undef ATT_LDK
    float mx = -INFINITY;
    if (IS_NA) {
        const int qcol = 16 * j + fr; const int cs = min(max(qcol - 8, 0), 48);
#pragma unroll
        for (int t = 0; t < 16; ++t) {
            const int kr = t >> 1, u = t & 1, dr = rs + kr - r + 7;
#pragma unroll
            for (int i = 0; i < 4; ++i) {
                const int kcol = kc0 + 8 * fq + 4 * u + i; const bool valid = kcol >= cs && kcol < cs + 16;
                const int dc = min(max(kcol - qcol + 15, 0), 30);
                const float v = valid ? s[t][i] + rpbh[dr * 31 + dc] : -INFINITY;
                s[t][i] = v; mx = fmaxf(mx, v);
            }
        }
    } else {
#pragma unroll
        for (int t = 0; t < 16; ++t)
#pragma unroll
            for (int i = 0; i < 4; ++i) { const float v = s[t][i] * qscale; s[t][i] = v; mx = fmaxf(mx, v); }
    }
    mx = fq_max(mx);
    float sum = 0.f;
#pragma unroll
    for (int t = 0; t < 16; ++t)
#pragma unroll
        for (int i = 0; i < 4; ++i) { const float p = __expf(s[t][i] - mx); s[t][i] = p; sum += p; }
    sum = fq_sum(sum);
    const float inv = 1.0f / sum;
    f32x4 o[D / 16];
#pragma unroll
    for (int nd = 0; nd < D / 16; ++nd) o[nd] = (f32x4){0.f, 0.f, 0.f, 0.f};
    const GAS bf16_t* vb0 = (const GAS bf16_t*)vtbase + (long)fr * vtstride + vkey0 + 8 * fq;
    bf16x8 vf[2][D / 16];
#pragma unroll
    for (int nd = 0; nd < D / 16; ++nd) vf[0][nd] = *(const GAS bf16x8*)(vb0 + (long)(16 * nd) * vtstride);
#pragma unroll
    for (int kr = 0; kr < 8; ++kr) {
        if (kr + 1 < 8) {
#pragma unroll
            for (int nd = 0; nd < D / 16; ++nd) vf[(kr + 1) & 1][nd] = *(const GAS bf16x8*)(vb0 + (kr + 1) * krstep + (long)(16 * nd) * vtstride); }
        const bf16x8 pa = pk8(s[2 * kr] * inv, s[2 * kr + 1] * inv);
#pragma unroll
        for (int nd = 0; nd < D / 16; ++nd) o[nd] = mfma16(pa, vf[kr & 1][nd], o[nd]);
    }
    float ro[4];
#pragma unroll
    for (int i = 0; i < 4; ++i) { float ss = 0.f;
#pragma unroll
        for (int nd = 0; nd < D / 16; ++nd) ss += o[nd][i] * o[nd][i];
        ss = fr_sum(ss); ro[i] = rsqrtf(ss * (1.0f / D) + EPS); }
#pragma unroll
    for (int nd = 0; nd < D / 16; ++nd) { const float g = ogain[16 * nd + fr];
#pragma unroll
        for (int i = 0; i < 4; ++i) y0[(size_t)(4 * fq + i) * DM + 16 * nd + fr] = f2bf(o[nd][i] * ro[i] * g); }
}

constexpr int GL_CUMF = 8192, GL_CUMB = GL_CUMF + 32768, GL_VTA = GL_CUMB + 32768, GL_KTF = GL_VTA + 36864, GL_KTB = GL_KTF + 18432;
constexpr int GL_G = 0, GL_CUM = 4096, GL_VT = GL_CUM + 32768, GL_KT = GL_VT + 36864, GL_QE = GL_KT, GL_KE = GL_QE + 17408, GL_RED = GL_KE + 17408;
constexpr int VTS = 72, QES = 136;

__device__ __forceinline__ void gla_cum(const Args& a, LAS unsigned char* lds, int l, int h, int t0, int dir) {
    const int tid = tidx();
    LAS float* Gs = (LAS float*)(lds + GL_G); LAS float* CUM = (LAS float*)(lds + GL_CUM);
    const bf16_t* P = (const bf16_t*)(a.ws + WS_P);
    if (tid < 128) { const int s = tid >> 1, hf = tid & 1;
        const u32x4 w = *(const u32x4*)(P + (size_t)(t0 + s) * INP + C_GG + 16 * dir + 8 * hf);
        LAS float* g = Gs + s * 16 + 8 * hf;
#pragma unroll
        for (int e = 0; e < 4; ++e) { g[2 * e] = bflo(w[e]); g[2 * e + 1] = bfhi(w[e]); } }
    const int d = tid & 127, sg = tid >> 7;
    const float* wg = a.in[dir ? 6 : 4] + (size_t)l * 16 * 512 + 128 * h + d;
    float w[16];
#pragma unroll
    for (int jj = 0; jj < 16; ++jj) w[jj] = wg[jj * 512];
    const float bias = a.in[dir ? 7 : 5][l * 512 + 128 * h + d];
    __syncthreads();
#pragma unroll 4
    for (int i = 0; i < 16; ++i) { const int s = sg * 16 + i; const LAS f32x4* g4 = (const LAS f32x4*)(Gs + s * 16);
        float z = bias;
#pragma unroll
        for (int q = 0; q < 4; ++q) { const f32x4 g = g4[q]; z += g[0] * w[4 * q] + g[1] * w[4 * q + 1] + g[2] * w[4 * q + 2] + g[3] * w[4 * q + 3]; }
        const float ls = fminf(z, 0.f) - __logf(1.0f + __expf(-fabsf(z)));
        CUM[s * 128 + d] = ls * (1.0f / 16.0f); }
    __syncthreads();
    if (tid < 256) { const int hf = tid >> 7; float run = 0.f;
#pragma unroll 8
        for (int p = 0; p < 32; ++p) { const int pp = 32 * hf + p, s = dir ? 63 - pp : pp; run += CUM[s * 128 + d]; CUM[s * 128 + d] = run; } }
    __syncthreads();
    { const int sl = dir ? 32 : 31; const float tot = CUM[sl * 128 + d];
#pragma unroll
      for (int i = 0; i < 8; ++i) { const int pp = 32 + 8 * sg + i, s = dir ? 63 - pp : pp; CUM[s * 128 + d] += tot; } }
    __syncthreads();
}

__device__ __forceinline__ void gla_vt(const Args& a, LAS unsigned char* lds, int h, int t0) {
    const int tid = tidx(), e = tid & 255, sg = tid >> 8;
    const bf16_t* P = (const bf16_t*)(a.ws + WS_P) + (size_t)t0 * INP + C_GV + 256 * h + e;
    LAS bf16_t* VT = (LAS bf16_t*)(lds + GL_VT);
#pragma unroll
    for (int it = 0; it < 4; ++it) { const int s0 = 8 * (sg + 2 * it); unsigned short v[8];
#pragma unroll
        for (int i = 0; i < 8; ++i) v[i] = P[(size_t)(s0 + i) * INP];
        u32x4 w; w.x = v[0] | ((unsigned)v[1] << 16); w.y = v[2] | ((unsigned)v[3] << 16); w.z = v[4] | ((unsigned)v[5] << 16); w.w = v[6] | ((unsigned)v[7] << 16);
        *(LAS u32x4*)(VT + e * VTS + s0) = w; }
}

struct GlaVtRegs { unsigned short v[4][8]; };
__device__ __forceinline__ void gla_vt_load(const Args& a, GlaVtRegs& R, int h, int t0) {
    const int tid = tidx(), e = tid & 255, sg = tid >> 8;
    const GAS bf16_t* P = (const GAS bf16_t*)(a.ws + WS_P) + (size_t)t0 * INP + C_GV + 256 * h + e;
#pragma unroll
    for (int it = 0; it < 4; ++it)
#pragma unroll
        for (int i = 0; i < 8; ++i) R.v[it][i] = P[(size_t)(8 * (sg + 2 * it) + i) * INP];
}
__device__ __forceinline__ void gla_vt_store(const GlaVtRegs& R, LAS bf16_t* VT) {
    const int tid = tidx(), e = tid & 255, sg = tid >> 8;
#pragma unroll
    for (int it = 0; it < 4; ++it) { const int s0 = 8 * (sg + 2 * it);
        u32x4 w; w.x = R.v[it][0] | ((unsigned)R.v[it][1] << 16); w.y = R.v[it][2] | ((unsigned)R.v[it][3] << 16); w.z = R.v[it][4] | ((unsigned)R.v[it][5] << 16); w.w = R.v[it][6] | ((unsigned)R.v[it][7] << 16);
        *(LAS u32x4*)(VT + e * VTS + s0) = w; }
}

struct GlaGateRegs { bf16x8 af, ab, wfr[4], wbr[4]; float bfv[4], bbv[4]; };
__device__ __forceinline__ void gla_gate_load(const Args& a, GlaGateRegs& R, int l, int h, int t0, int wave, int fr, int fq) {
    const int mt = wave & 3, dh = wave >> 2;
    const GAS bf16_t* gp = (const GAS bf16_t*)(a.ws + WS_P) + (size_t)(t0 + 16 * mt + fr) * INP + C_GG;
    R.af = *(const GAS bf16x8*)(gp + 8 * fq); R.ab = *(const GAS bf16x8*)(gp + ((8 * fq + 16) & 31));
    const GAS bf16_t* wt = (const GAS bf16_t*)(a.ws + WS_WG2T) + ((size_t)(l * 2) * 512 + 128 * h + 64 * dh + fr) * 32 + 8 * fq;
#pragma unroll
    for (int dt = 0; dt < 4; ++dt) { R.wfr[dt] = *(const GAS bf16x8*)(wt + dt * 16 * 32); R.wbr[dt] = *(const GAS bf16x8*)(wt + 512 * 32 + dt * 16 * 32);
        R.bfv[dt] = a.in[5][l * 512 + 128 * h + 64 * dh + 16 * dt + fr]; R.bbv[dt] = a.in[7][l * 512 + 128 * h + 64 * dh + 16 * dt + fr]; }
}
__device__ __forceinline__ void gla_gate_compute(const GlaGateRegs& R, LAS float* CF, LAS float* CB, int wave, int fr, int fq) {
    const int mt = wave & 3, dh = wave >> 2;
#pragma unroll
    for (int dt = 0; dt < 4; ++dt) {
        const f32x4 zf = mfma16(R.af, R.wfr[dt], (f32x4){0.f, 0.f, 0.f, 0.f}), zb = mfma16(R.ab, R.wbr[dt], (f32x4){0.f, 0.f, 0.f, 0.f});
        const int dcol = 64 * dh + 16 * dt + fr;
#pragma unroll
        for (int i = 0; i < 4; ++i) { const int srow = 16 * mt + 4 * fq + i; const float vf = zf[i] + R.bfv[dt], vb = zb[i] + R.bbv[dt];
            CF[srow * 128 + dcol] = (fminf(vf, 0.f) - __logf(1.0f + __expf(-fabsf(vf)))) * (1.0f / 16.0f);
            CB[srow * 128 + dcol] = (fminf(vb, 0.f) - __logf(1.0f + __expf(-fabsf(vb)))) * (1.0f / 16.0f); }
    }
}

__device__ __forceinline__ void gla_a_unit(const Args& a, LAS unsigned char* lds, int l, int unit) {
    const int tid = tidx(), lane = tid & 63, wave = tid >> 6, fr = lane & 15, fq = lane >> 4;
    const int n = unit & 127, h = (unit >> 7) & 3, b = unit >> 9, t0 = b * SEQ + n * 64;
    const int d = tid & 127, sg = tid >> 7;
    const GAS bf16_t* P = (const GAS bf16_t*)(a.ws + WS_P);
    LAS float* Gs = (LAS float*)(lds + GL_G); LAS float* CF = (LAS float*)(lds + GL_CUMF); LAS float* CB = (LAS float*)(lds + GL_CUMB);
    LAS bf16_t* VT = (LAS bf16_t*)(lds + GL_VTA); LAS bf16_t* KTF = (LAS bf16_t*)(lds + GL_KTF); LAS bf16_t* KTB = (LAS bf16_t*)(lds + GL_KTB);
    GAS bf16_t* ST = (GAS bf16_t*)(a.ws + WS_ST); GAS float* DEC = (GAS float*)(a.ws + WS_DEC);
    GlaGateRegs GR; gla_gate_load(a, GR, l, h, t0, wave, fr, fq);
    GlaVtRegs VR; gla_vt_load(a, VR, h, t0);
    __syncthreads();
    gla_vt_store(VR, VT);
    unsigned short kv[2][8];
    { const GAS bf16_t* kp = P + (size_t)t0 * INP + C_GK + 128 * h + d;
#pragma unroll
      for (int it = 0; it < 2; ++it)
#pragma unroll
          for (int i = 0; i < 8; ++i) kv[it][i] = kp[(size_t)(8 * (sg + 4 * it) + i) * INP]; }
    gla_gate_compute(GR, CF, CB, wave, fr, fq);
    __syncthreads();
    { const int dir = tid >> 8, hf = (tid >> 7) & 1; LAS float* C = dir ? CB : CF; float run = 0.f;
#pragma unroll 8
      for (int p = 0; p < 32; ++p) { const int pp = 32 * hf + p, s = dir ? 63 - pp : pp; run += C[s * 128 + d]; C[s * 128 + d] = run; } }
    __syncthreads();
    { const float tf = CF[31 * 128 + d], tb = CB[32 * 128 + d];
#pragma unroll
      for (int i = 0; i < 8; ++i) { const int pp = 32 + 8 * sg + i; CF[pp * 128 + d] += tf; CB[(63 - pp) * 128 + d] += tb; } }
    __syncthreads();
    { const float lf = CF[63 * 128 + d], lb = CB[d];
#pragma unroll
      for (int it = 0; it < 2; ++it) { const int s0 = 8 * (sg + 4 * it); float vf[8], vb[8];
#pragma unroll
          for (int i = 0; i < 8; ++i) { const float k = bf2f(kv[it][i]); vf[i] = k * __expf(lf - CF[(s0 + i) * 128 + d]); vb[i] = k * __expf(lb - CB[(s0 + i) * 128 + d]); }
          u32x4 w; w.x = cvt_pk_bf16(vf[0], vf[1]); w.y = cvt_pk_bf16(vf[2], vf[3]); w.z = cvt_pk_bf16(vf[4], vf[5]); w.w = cvt_pk_bf16(vf[6], vf[7]);
          *(LAS u32x4*)(KTF + d * VTS + s0) = w;
          w.x = cvt_pk_bf16(vb[0], vb[1]); w.y = cvt_pk_bf16(vb[2], vb[3]); w.z = cvt_pk_bf16(vb[4], vb[5]); w.w = cvt_pk_bf16(vb[6], vb[7]);
          *(LAS u32x4*)(KTB + d * VTS + s0) = w; }
      if (tid < 128) { DEC[((size_t)unit * 2 + 0) * 128 + d] = __expf(lf); DEC[((size_t)unit * 2 + 1) * 128 + d] = __expf(lb); }
    }
    __syncthreads();
    bf16x8 vb[2][2];
#pragma unroll
    for (int et = 0; et < 2; ++et)
#pragma unroll
        for (int ks = 0; ks < 2; ++ks) vb[et][ks] = *(const LAS bf16x8*)(VT + (32 * wave + 16 * et + fr) * VTS + 32 * ks + 8 * fq);
#pragma unroll
    for (int dir = 0; dir < 2; ++dir) { const LAS bf16_t* KT = dir ? KTB : KTF; GAS bf16_t* stp = ST + ((size_t)unit * 2 + dir) * 32768;
#pragma unroll
        for (int dt = 0; dt < 8; ++dt) {
            bf16x8 ka[2];
#pragma unroll
            for (int ks = 0; ks < 2; ++ks) ka[ks] = *(const LAS bf16x8*)(KT + (16 * dt + fr) * VTS + 32 * ks + 8 * fq);
#pragma unroll
            for (int et = 0; et < 2; ++et) { f32x4 acc = (f32x4){0.f, 0.f, 0.f, 0.f};
                acc = mfma16(ka[0], vb[et][0], acc); acc = mfma16(ka[1], vb[et][1], acc);
                *(GAS u32x2*)(stp + (size_t)(((2 * wave + et) * 8 + dt) * 256 + fr * 16 + 4 * fq)) = pk4(acc); }
        } }
}

__device__ __forceinline__ void gla_scan(const Args& a, int G) {
    const GAS bf16_t* ST = (const GAS bf16_t*)(a.ws + WS_ST); GAS bf16_t* ST2 = (GAS bf16_t*)(a.ws + WS_ST2); const GAS float* DEC = (const GAS float*)(a.ws + WS_DEC);
    for (int gid = blockIdx.x * NTHR + tidx(); gid < 16 * 8192; gid += G * NTHR) {
        const int seq = gid >> 13, off = (gid & 8191) * 4, dir = seq & 1, bh = seq >> 1, d = 16 * ((off >> 8) & 7) + (off & 15);
        f32x4 st = (f32x4){0.f, 0.f, 0.f, 0.f};
        for (int s0 = 0; s0 < 128; s0 += 8) {
            u32x2 kv[8]; f32x4 dc[8];
#pragma unroll
            for (int j = 0; j < 8; ++j) { const int n = dir ? 127 - (s0 + j) : (s0 + j); const size_t u2 = (size_t)(bh * 128 + n) * 2 + dir;
                kv[j] = *(const GAS u32x2*)(ST + u2 * 32768 + off); dc[j] = *(const GAS f32x4*)(DEC + u2 * 128 + d); }
#pragma unroll
            for (int j = 0; j < 8; ++j) { const int n = dir ? 127 - (s0 + j) : (s0 + j); const size_t u2 = (size_t)(bh * 128 + n) * 2 + dir;
                *(GAS u32x2*)(ST2 + u2 * 32768 + off) = pk4(st);
                st[0] = dc[j][0] * st[0] + bflo(kv[j].x); st[1] = dc[j][1] * st[1] + bfhi(kv[j].x); st[2] = dc[j][2] * st[2] + bflo(kv[j].y); st[3] = dc[j][3] * st[3] + bfhi(kv[j].y); }
        }
    }
}

constexpr int GL2_G = 0, GL2_CF = 8192, GL2_CB = GL2_CF + 32768, GL2_VT = GL2_CB + 32768, GL2_QE = GL2_VT + 36864, GL2_KE = GL2_QE + 17408;
__device__ __forceinline__ void gla_c_unit(const Args& a, LAS unsigned char* lds, int l, int unit) {
    const int tid = tidx(), lane = tid & 63, wave = tid >> 6, fr = lane & 15, fq = lane >> 4;
    const int n = unit & 127, h = (unit >> 7) & 3, b = unit >> 9, t0 = b * SEQ + n * 64;
    const int tt = wave & 3, eh = wave >> 2, d = tid & 127, sg = tid >> 7;
    const GAS bf16_t* P = (const GAS bf16_t*)(a.ws + WS_P);
    LAS float* Gs = (LAS float*)(lds + GL2_G); LAS float* CF = (LAS float*)(lds + GL2_CF); LAS float* CB = (LAS float*)(lds + GL2_CB);
    LAS bf16_t* VT = (LAS bf16_t*)(lds + GL2_VT); LAS bf16_t* QE = (LAS bf16_t*)(lds + GL2_QE); LAS bf16_t* KE = (LAS bf16_t*)(lds + GL2_KE); LAS float* RED = (LAS float*)(lds + GL2_G);
    const GAS bf16_t* ST = (const GAS bf16_t*)(a.ws + WS_ST2);
    f32x4 o[2][4];
#pragma unroll
    for (int et = 0; et < 2; ++et)
#pragma unroll
        for (int tq = 0; tq < 4; ++tq) o[et][tq] = (f32x4){0.f, 0.f, 0.f, 0.f};
    bf16x8 sf[2][2][4];
    const GAS bf16x8* sp0 = (const GAS bf16x8*)(ST + (size_t)unit * 2 * 32768 + (size_t)(2 * wave * 8 + (fq >> 1)) * 256 + fr * 16 + 8 * (fq & 1));
    {
#pragma unroll
      for (int et = 0; et < 2; ++et)
#pragma unroll
          for (int ks = 0; ks < 4; ++ks) sf[0][et][ks] = sp0[et * 256 + ks * 64]; }
    u32x2 rw[2][4];
    const int sb = tid >> 3, d0 = 16 * (tid & 7);
    u32x4 qw[2], kw[2];
    { const GAS u32x4* qp = (const GAS u32x4*)(P + (size_t)(t0 + sb) * INP + C_GQ + 128 * h + d0); const GAS u32x4* kp = (const GAS u32x4*)(P + (size_t)(t0 + sb) * INP + C_GK + 128 * h + d0);
      qw[0] = qp[0]; qw[1] = qp[1]; kw[0] = kp[0]; kw[1] = kp[1]; }
    GlaGateRegs GR; gla_gate_load(a, GR, l, h, t0, wave, fr, fq);
    GlaVtRegs VR; gla_vt_load(a, VR, h, t0);
    __syncthreads();
    gla_vt_store(VR, VT);
    gla_gate_compute(GR, CF, CB, wave, fr, fq);
    __syncthreads();
    { const int dir = tid >> 8, hf = (tid >> 7) & 1; LAS float* C = dir ? CB : CF; float run = 0.f;
#pragma unroll 8
      for (int p = 0; p < 32; ++p) { const int pp = 32 * hf + p, s = dir ? 63 - pp : pp; run += C[s * 128 + d]; C[s * 128 + d] = run; } }
    __syncthreads();
    { const float tf = CF[31 * 128 + d], tb = CB[32 * 128 + d];
#pragma unroll
      for (int i = 0; i < 8; ++i) { const int pp = 32 + 8 * sg + i; CF[pp * 128 + d] += tf; CB[(63 - pp) * 128 + d] += tb; } }
    __syncthreads();
    const int t = 16 * tt + fr;
#pragma unroll
    for (int dir = 0; dir < 2; ++dir) {
        { const LAS float* C = dir ? CB : CF;
#pragma unroll
          for (int c = 0; c < 2; ++c) { const LAS f32x4* cp = (const LAS f32x4*)(C + sb * 128 + d0 + 8 * c); const f32x4 c0 = cp[0], c1 = cp[1];
              const float cv[8] = {c0[0], c0[1], c0[2], c0[3], c1[0], c1[1], c1[2], c1[3]}; u32x4 qo, ko;
#pragma unroll
              for (int e = 0; e < 4; ++e) {
                  qo[e] = cvt_pk_bf16(bflo(qw[c][e]) * __expf(cv[2 * e]), bfhi(qw[c][e]) * __expf(cv[2 * e + 1]));
                  ko[e] = cvt_pk_bf16(bflo(kw[c][e]) * __expf(-cv[2 * e]), bfhi(kw[c][e]) * __expf(-cv[2 * e + 1])); }
              *(LAS u32x4*)(QE + sb * QES + d0 + 8 * c) = qo; *(LAS u32x4*)(KE + sb * QES + d0 + 8 * c) = ko; } }
        __syncthreads();
        bf16x8 pb[4][2];
#pragma unroll
        for (int sgi = 0; sgi < 2; ++sgi) {
            bf16x8 kf[2][4];
#pragma unroll
            for (int u = 0; u < 2; ++u) { const int srow = 32 * sgi + 8 * (fr >> 2) + (fr & 3) + 4 * u;
#pragma unroll
                for (int ks = 0; ks < 4; ++ks) kf[u][ks] = *(const LAS bf16x8*)(KE + srow * QES + 32 * ks + 8 * fq); }
#pragma unroll
            for (int tq = 0; tq < 4; ++tq) { const int tcol = 16 * tq + fr; bf16x8 qf[4]; f32x4 sc[2];
#pragma unroll
                for (int ks = 0; ks < 4; ++ks) qf[ks] = *(const LAS bf16x8*)(QE + (16 * tq + fr) * QES + 32 * ks + 8 * fq);
#pragma unroll
                for (int u = 0; u < 2; ++u) { f32x4 acc = (f32x4){0.f, 0.f, 0.f, 0.f};
#pragma unroll
                    for (int ks = 0; ks < 4; ++ks) acc = mfma16(kf[u][ks], qf[ks], acc);
#pragma unroll
                    for (int i = 0; i < 4; ++i) { const int srow = 32 * sgi + 8 * fq + 4 * u + i; const bool keep = dir ? (srow > tcol) : (srow <= tcol); acc[i] = keep ? acc[i] : 0.f; }
                    sc[u] = acc; }
                pb[tq][sgi] = pk8(sc[0], sc[1]); } }
        if (dir == 0) {
#pragma unroll
            for (int et = 0; et < 2; ++et)
#pragma unroll
                for (int ks = 0; ks < 4; ++ks) sf[1][et][ks] = sp0[4096 + et * 256 + ks * 64];
        } else {
            const GAS bf16_t* rp = P + (size_t)(t0 + fr) * INP + C_GR + 256 * h + 32 * wave + 4 * fq;
#pragma unroll
            for (int et = 0; et < 2; ++et)
#pragma unroll
                for (int tq = 0; tq < 4; ++tq) rw[et][tq] = *(const GAS u32x2*)(rp + (size_t)(16 * tq) * INP + 16 * et); }
        bf16x8 vf[2][2];
#pragma unroll
        for (int et = 0; et < 2; ++et)
#pragma unroll
            for (int sgi = 0; sgi < 2; ++sgi) vf[et][sgi] = *(const LAS bf16x8*)(VT + (32 * wave + 16 * et + fr) * VTS + 32 * sgi + 8 * fq);
#pragma unroll
        for (int tq = 0; tq < 4; ++tq) { bf16x8 qf[4];
#pragma unroll
            for (int ks = 0; ks < 4; ++ks) qf[ks] = *(const LAS bf16x8*)(QE + (16 * tq + fr) * QES + 32 * ks + 8 * fq);
#pragma unroll
            for (int et = 0; et < 2; ++et) { f32x4 acc = o[et][tq];
#pragma unroll
                for (int sgi = 0; sgi < 2; ++sgi) acc = mfma16(vf[et][sgi], pb[tq][sgi], acc);
#pragma unroll
                for (int ks = 0; ks < 4; ++ks) acc = mfma16(sf[dir][et][ks], qf[ks], acc);
                o[et][tq] = acc; } }
        if (dir == 0) __syncthreads();
    }
#pragma unroll
    for (int tq = 0; tq < 4; ++tq) { float ss = dot4(o[0][tq]) + dot4(o[1][tq]); ss = fq_sum(ss); if (fq == 0) RED[wave * 64 + 16 * tq + fr] = ss; }
    __syncthreads();
    const float* gn = a.in[8] + l * 1024 + 256 * h; GAS bf16_t* Y = (GAS bf16_t*)(a.ws + WS_Y);
#pragma unroll
    for (int tq = 0; tq < 4; ++tq) { const int t = 16 * tq + fr; float tot = 0.f;
#pragma unroll
        for (int w8 = 0; w8 < 8; ++w8) tot += RED[w8 * 64 + t];
        const float rstd = rsqrtf(tot * (1.0f / 256.0f) + EPS);
#pragma unroll
        for (int et = 0; et < 2; ++et) { const int e = 32 * wave + 16 * et + 4 * fq;
            const f32x4 g = *(const f32x4*)(gn + e);
            const float r4[4] = {bflo(rw[et][tq].x), bfhi(rw[et][tq].x), bflo(rw[et][tq].y), bfhi(rw[et][tq].y)}; f32x4 y;
#pragma unroll
            for (int i = 0; i < 4; ++i) y[i] = o[et][tq][i] * rstd * g[i] * (r4[i] * __builtin_amdgcn_rcpf(1.0f + __expf(-r4[i])));
            *(GAS u32x2*)(Y + (size_t)(t0 + t) * DM + 256 * h + e) = pk4(y); } }
}

constexpr int NA_RPB = 147456, NA_VL = 73728;
__device__ __forceinline__ void na_attn_block(const Args& a, LAS unsigned char* lds, int l, int u) {
    const int tid = tidx(), lane = tid & 63, wave = tid >> 6, fr = lane & 15, fq = lane >> 4;
    const int b = u >> 9, h = (u >> 6) & 7, r0 = 2 * (u & 63), r = r0 + (wave >> 2), j = wave & 3;
    const int rs0 = min(max(r0 - 4, 0), 120), rs = min(max(r - 4, 0), 120), krw = rs - rs0, kc0 = min(max(16 * j - 8, 0), 32);
    const int tq0 = b * SEQ + r * 64 + 16 * j;
    const GAS bf16_t* P = (const GAS bf16_t*)(a.ws + WS_P);
    LAS unsigned char* KL = lds; LAS unsigned char* VL = lds + NA_VL; LAS float* rpbh = (LAS float*)(lds + NA_RPB);
    bf16x8 qf[2];
    { const GAS bf16_t* qrow = P + (size_t)(tq0 + fr) * INP + C_NQ + 64 * h;
      qf[0] = *(const GAS bf16x8*)(qrow + 8 * fq); qf[1] = *(const GAS bf16x8*)(qrow + 32 + 8 * fq); }
    u32x4 kst[9], vst[9];
    { const GAS bf16_t* vg = (const GAS bf16_t*)(a.ws + WS_NVT) + (size_t)(b * 512 + 64 * h) * 8192 + rs0 * 64;
#pragma unroll
      for (int i = 0; i < 9; ++i) { const int ci = tid + 512 * i;
          { const int kk = ci >> 3, ch = ci & 7, trow = min(rs0 + (kk >> 6), 127);
            kst[i] = *(const GAS u32x4*)(P + (size_t)(b * SEQ + trow * 64 + (kk & 63)) * INP + C_NK + 64 * h + 8 * ch); }
          { const int dd = ci / 72, c = ci - dd * 72; vst[i] = *(const GAS u32x4*)(vg + (size_t)dd * 8192 + 8 * c); } } }
    const float rp = tid < 465 ? a.in[11][(l * 8 + h) * 465 + tid] : 0.f;
    __syncthreads();
#pragma unroll
    for (int i = 0; i < 9; ++i) { const int ci = tid + 512 * i;
        { const int kk = ci >> 3, ch = ci & 7, col = kk & 63, sw = ((col >> 1) & 1) | (((col >> 3) & 3) << 1); *(LAS u32x4*)(KL + kk * 128 + ((ch ^ sw) << 4)) = kst[i]; }
        { const int dd = ci / 72, c = ci - dd * 72; *(LAS u32x4*)(VL + dd * 1152 + ((c ^ ((dd >> 1) & 7)) << 4)) = vst[i]; } }
    if (tid < 465) rpbh[tid] = rp;
    __syncthreads();
    f32x4 s[16];
    const int kro = 8 * (fr >> 2) + (fr & 3);
#pragma unroll
    for (int t = 0; t < 16; ++t) { const int kr = t >> 1, u2 = t & 1, col = kc0 + kro + 4 * u2, sw = ((col >> 1) & 1) | (((col >> 3) & 3) << 1);
        const LAS unsigned char* kp = KL + ((krw + kr) * 64 + col) * 128; f32x4 acc = (f32x4){0.f, 0.f, 0.f, 0.f};
#pragma unroll
        for (int ks = 0; ks < 2; ++ks) acc = mfma16(*(const LAS bf16x8*)(kp + (((4 * ks + fq) ^ sw) << 4)), qf[ks], acc);
        s[t] = acc; }
    float mx = -INFINITY;
    { const int qcol = 16 * j + fr; const int cs = min(max(qcol - 8, 0), 48);
#pragma unroll
      for (int t = 0; t < 16; ++t) { const int kr = t >> 1, u2 = t & 1, dr = rs + kr - r + 7;
#pragma unroll
          for (int i = 0; i < 4; ++i) { const int kcol = kc0 + 8 * fq + 4 * u2 + i; const bool valid = kcol >= cs && kcol < cs + 16;
              const int dc = min(max(kcol - qcol + 15, 0), 30);
              const float v = valid ? s[t][i] + rpbh[dr * 31 + dc] : -INFINITY;
              s[t][i] = v; mx = fmaxf(mx, v); } } }
    mx = fq_max(mx);
    float sum = 0.f;
#pragma unroll
    for (int t = 0; t < 16; ++t)
#pragma unroll
        for (int i = 0; i < 4; ++i) { const float p = __expf(s[t][i] - mx); s[t][i] = p; sum += p; }
    sum = fq_sum(sum);
    const float inv = 1.0f / sum;
    f32x4 o[4];
#pragma unroll
    for (int nd = 0; nd < 4; ++nd) o[nd] = (f32x4){0.f, 0.f, 0.f, 0.f};
#pragma unroll
    for (int kr = 0; kr < 8; ++kr) { const bf16x8 pa = pk8(s[2 * kr] * inv, s[2 * kr + 1] * inv); const int c = (krw + kr) * 8 + (kc0 >> 3) + fq;
#pragma unroll
        for (int nd = 0; nd < 4; ++nd) o[nd] = mfma16(pa, *(const LAS bf16x8*)(VL + (16 * nd + fr) * 1152 + ((c ^ ((fr >> 1) & 7)) << 4)), o[nd]); }
    float ro[4];
#pragma unroll
    for (int i = 0; i < 4; ++i) { float q2 = 0.f;
#pragma unroll
        for (int nd = 0; nd < 4; ++nd) q2 += o[nd][i] * o[nd][i];
        q2 = fr_sum(q2); ro[i] = rsqrtf(q2 * (1.0f / 64.0f) + EPS); }
    const float* ogain = a.in[12] + l * 512 + 64 * h; GAS bf16_t* y0 = (GAS bf16_t*)(a.ws + WS_Y) + (size_t)tq0 * DM + 1024 + 64 * h;
#pragma unroll
    for (int nd = 0; nd < 4; ++nd) { const float g = ogain[16 * nd + fr];
#pragma unroll
        for (int i = 0; i < 4; ++i) y0[(size_t)(4 * fq + i) * DM + 16 * nd + fr] = f2bf(o[nd][i] * ro[i] * g); }
}

__device__ __forceinline__ void mem_attn_block(const Args& a, LAS unsigned char* lds, int l, int u) {
    const int tid = tidx(), lane = tid & 63, wave = tid >> 6, fr = lane & 15, fq = lane >> 4;
    const int b = u >> 8, h = (u >> 6) & 3, qblk = u & 63, tq0 = b * SEQ + qblk * 128 + 16 * wave;
    const size_t hb = (size_t)((l * 2 + b) * 4 + h) * 32768;
    const GAS u32x4* kg = (const GAS u32x4*)((const GAS bf16_t*)(a.ws + WS_KM) + hb); const GAS u32x4* vg = (const GAS u32x4*)((const GAS bf16_t*)(a.ws + WS_VMT) + hb);
    LAS unsigned char* KL = lds; LAS unsigned char* VL = lds + 65536;
    const GAS bf16_t* qrow = (const GAS bf16_t*)(a.ws + WS_P) + (size_t)(tq0 + fr) * INP + C_MQ + 128 * h;
    bf16x8 qf[4];
#pragma unroll
    for (int ks = 0; ks < 4; ++ks) qf[ks] = *(const GAS bf16x8*)(qrow + 32 * ks + 8 * fq);
    u32x4 kst[8], vst[8];
#pragma unroll
    for (int i = 0; i < 8; ++i) { kst[i] = kg[tid + 512 * i]; vst[i] = vg[tid + 512 * i]; }
    __syncthreads();
#pragma unroll
    for (int i = 0; i < 8; ++i) { const int ci = tid + 512 * i;
        { const int key = ci >> 4, c = ci & 15, sw = (key & 3) | (((key >> 3) & 3) << 2); *(LAS u32x4*)(KL + key * 256 + ((c ^ sw) << 4)) = kst[i]; }
        { const int dd = ci >> 5, c = ci & 31; *(LAS u32x4*)(VL + dd * 512 + ((c ^ (dd & 15)) << 4)) = vst[i]; } }
    float ss = 0.f;
#pragma unroll
    for (int ks = 0; ks < 4; ++ks) { const u32x4 w = __builtin_bit_cast(u32x4, qf[ks]);
#pragma unroll
        for (int e = 0; e < 4; ++e) { const float lo = bflo(w[e]), hi = bfhi(w[e]); ss += lo * lo + hi * hi; } }
    ss = fq_sum(ss);
    const float qscale = rsqrtf(ss * (1.0f / 128.0f) + EPS);
    __syncthreads();
    f32x4 s[16];
    const int kro = 8 * (fr >> 2) + (fr & 3);
#pragma unroll
    for (int t = 0; t < 16; ++t) { const int R = 32 * (t >> 1) + kro + 4 * (t & 1), sw = (R & 3) | (((R >> 3) & 3) << 2);
        const LAS unsigned char* kp = KL + R * 256; f32x4 acc = (f32x4){0.f, 0.f, 0.f, 0.f};
#pragma unroll
        for (int ks = 0; ks < 4; ++ks) acc = mfma16(*(const LAS bf16x8*)(kp + (((4 * ks + fq) ^ sw) << 4)), qf[ks], acc);
        s[t] = acc; }
    float mx = -INFINITY;
#pragma unroll
    for (int t = 0; t < 16; ++t)
#pragma unroll
        for (int i = 0; i < 4; ++i) { const float v = s[t][i] * qscale; s[t][i] = v; mx = fmaxf(mx, v); }
    mx = fq_max(mx);
    float sum = 0.f;
#pragma unroll
    for (int t = 0; t < 16; ++t)
#pragma unroll
        for (int i = 0; i < 4; ++i) { const float p = __expf(s[t][i] - mx); s[t][i] = p; sum += p; }
    sum = fq_sum(sum);
    const float inv = 1.0f / sum;
    f32x4 o[8];
#pragma unroll
    for (int nd = 0; nd < 8; ++nd) o[nd] = (f32x4){0.f, 0.f, 0.f, 0.f};
#pragma unroll
    for (int kr = 0; kr < 8; ++kr) { const bf16x8 pa = pk8(s[2 * kr] * inv, s[2 * kr + 1] * inv);
#pragma unroll
        for (int nd = 0; nd < 8; ++nd) o[nd] = mfma16(pa, *(const LAS bf16x8*)(VL + (16 * nd + fr) * 512 + (((4 * kr + fq) ^ fr) << 4)), o[nd]); }
    float ro[4];
#pragma unroll
    for (int i = 0; i < 4; ++i) { float q2 = 0.f;
#pragma unroll
        for (int nd = 0; nd < 8; ++nd) q2 += o[nd][i] * o[nd][i];
        q2 = fr_sum(q2); ro[i] = rsqrtf(q2 * (1.0f / 128.0f) + EPS); }
    const float* ogain = a.in[17] + l * 512 + 128 * h; GAS bf16_t* y0 = (GAS bf16_t*)(a.ws + WS_Y) + (size_t)tq0 * DM + 1536 + 128 * h;
#pragma unroll
    for (int nd = 0; nd < 8; ++nd) { const float g = ogain[16 * nd + fr];
#pragma unroll
        for (int i = 0; i < 4; ++i) y0[(size_t)(4 * fq + i) * DM + 16 * nd + fr] = f2bf(o[nd][i] * ro[i] * g); }
}

__device__ __forceinline__ void gate_gemm(const Args& a, int l, int G) {
    const int tid = tidx(), lane = tid & 63, wave = tid >> 6, fr = lane & 15, fq = lane >> 4, mt = wave & 3, ct = wave >> 2;
    const GAS bf16_t* XB = (const GAS bf16_t*)(a.ws + WS_XB); const GAS bf16_t* Wg = (const GAS bf16_t*)(a.ws + WS_WIN + l * SZ_WIN) + (size_t)(5120 + 16 * ct + fr) * DM + 8 * fq;
    const GAS float* SSQ = (const GAS float*)(a.ws + WS_SSQ); GAS bf16_t* P = (GAS bf16_t*)(a.ws + WS_P);
    for (int it = blockIdx.x; it < MTOK / 64; it += G) {
        const int r0 = it * 64 + 16 * mt;
        const GAS bf16_t* ap = XB + (size_t)(r0 + fr) * DM + 8 * fq;
        f32x4 acc = (f32x4){0.f, 0.f, 0.f, 0.f};
#pragma unroll 1
        for (int k0 = 0; k0 < 64; k0 += 16) {
            bf16x8 af[16], bfr[16];
#pragma unroll
            for (int j = 0; j < 16; ++j) { af[j] = *(const GAS bf16x8*)(ap + 32 * (k0 + j)); bfr[j] = *(const GAS bf16x8*)(Wg + 32 * (k0 + j)); }
#pragma unroll
            for (int j = 0; j < 16; ++j) acc = mfma16(af[j], bfr[j], acc);
        }
#pragma unroll
        for (int i = 0; i < 4; ++i) { const int row = r0 + 4 * fq + i; const GAS f32x4* sp = (const GAS f32x4*)(SSQ + (size_t)row * 32); float sacc = 0.f;
#pragma unroll
            for (int q = 0; q < 8; ++q) { const f32x4 v = sp[q]; sacc += (v[0] + v[1]) + (v[2] + v[3]); }
            const float r = rsqrtf(sacc * (1.0f / DM) + EPS);
            P[(size_t)row * INP + C_GG + 16 * ct + fr] = f2bf(acc[i] * r); }
    }
}

__global__ void __launch_bounds__(NTHR, 2) fwd_kernel(Args a) {
    extern __shared__ __attribute__((aligned(16))) unsigned char lds_raw[];
    LAS unsigned char* lds = (LAS unsigned char*)lds_raw;
    cg::grid_group grid = cg::this_grid();
    const int G = gridDim.x;
    if (tidx() < 4) ((LAS unsigned*)(lds + LDS_XB))[tidx()] = 0u;
    __syncthreads();
    XcdBarrier xbar; xbar.bar = (unsigned*)a.ws; xbar.x = 0u; xbar.st = (volatile LAS unsigned*)(lds + LDS_XB);
    for (int ph = a.ph_lo; ph < a.ph_hi; ++ph) {
        unsigned char* ws = a.ws; asm volatile("" : "+s"(ws));
        bf16_t* P = (bf16_t*)(ws + WS_P); bf16_t* XB = (bf16_t*)(ws + WS_XB); float* SSQ = (float*)(ws + WS_SSQ); bf16_t* Y = (bf16_t*)(ws + WS_Y); bf16_t* Hb = (bf16_t*)(ws + WS_H);
        bf16_t* NVT = (bf16_t*)(ws + WS_NVT);
        if (ph == 0) { if (blockIdx.x == 0) for (int i = tidx(); i < XCD_BAR_WORDS; i += NTHR) ((GAS unsigned*)a.ws)[i] = 0u;
                       p0_prologue(a, lds, G); }
        else {
            const int l = (ph - 1) / 7, sub = (ph - 1) % 7;
            if (sub == 0) { if (PHM & 2) {
                if (l == 0) {
                    pg8::Gemm g{(const bf16_t*)(ws + WS_MEMN), (const bf16_t*)(ws + WS_WMEM), 512, 4096, DM}; pg8::StaticOrder S; S.init(512, 4096, G, (int)blockIdx.x);
                    EpiPlain E{(bf16_t*)(ws + WS_MKV), 4096};
                    pg8::gemm_phase<EpiPlain, pg8::StaticOrder, true, true>(lds, g, S, E);
                }
                pg8::Gemm g{XB, (const bf16_t*)(ws + WS_WIN + l * SZ_WIN), MTOK, 5120, DM}; pg8::StaticOrder S; S.init(MTOK, 5120, G, (int)blockIdx.x);
                LAS float* slot = (LAS float*)(lds + 131072) + tidx() * 9; slot[8] = __int_as_float(-1);
                EpiIn E{P, NVT, SSQ, a.in[9] + l * 64, a.in[10] + l * 64, slot};
                pg8::gemm_phase<EpiIn, pg8::StaticOrder, true, true>(lds, g, S, E);
                gate_gemm(a, l, G); }
            } else if (sub == 1) { if (PHM & 4) {
                if (l == 0) memprep(a, G);
                for (int u = blockIdx.x; u < 2048; u += G) gla_a_unit(a, lds, l, u);
                __syncthreads();
                for (int u = blockIdx.x; u < 1024; u += G) na_attn_block(a, lds, l, u);
                }
            } else if (sub == 2) { if (PHM & 8) {
                gla_scan(a, G);
                for (int u = blockIdx.x; u < 512; u += G) mem_attn_block(a, lds, l, u);
                }
            } else if (sub == 3) {
                if (PHM & 16) for (int u = blockIdx.x; u < 2048; u += G) gla_c_unit(a, lds, l, u);
            } else if (sub == 4) { if (PHM & 32) {
                pg8::Gemm g{Y, (const bf16_t*)(ws + WS_WOUT + l * SZ_WOUT), MTOK, DM, DM}; pg8::StaticOrder S; S.init(MTOK, DM, G, (int)blockIdx.x);
                EpiRes E{l == 0 ? a.in[0] : a.out, a.out, XB, SSQ};
                pg8::gemm_phase<EpiRes, pg8::StaticOrder, true, true>(lds, g, S, E); }
            } else if (sub == 5) { if (PHM & 64) {
                pg8::Gemm g{XB, (const bf16_t*)(ws + WS_W13 + l * SZ_W13), MTOK, 2 * DFF, DM}; pg8::StaticOrder S; S.init(MTOK, 2 * DFF, G, (int)blockIdx.x);
                LAS float* slot = (LAS float*)(lds + 131072) + tidx() * 9; slot[8] = __int_as_float(-1);
                EpiSwiglu E{Hb, SSQ, slot};
                pg8::gemm_phase<EpiSwiglu, pg8::StaticOrder, true, true>(lds, g, S, E); }
            } else { if (PHM & 128) {
                pg8::Gemm g{Hb, (const bf16_t*)(ws + WS_W2 + l * SZ_W2), MTOK, DM, DFF}; pg8::StaticOrder S; S.init(MTOK, DM, G, (int)blockIdx.x);
                EpiRes E{a.out, a.out, XB, SSQ};
                pg8::gemm_phase<EpiRes, pg8::StaticOrder, true, true>(lds, g, S, E); }
            }
        }
        if (ph + 1 < a.ph_hi) {
            if (ph == a.ph_lo) { asm volatile("s_waitcnt vmcnt(0)" ::: "memory"); grid.sync(); __builtin_amdgcn_fence(__ATOMIC_ACQUIRE, "agent"); asm volatile("s_waitcnt vmcnt(0)" ::: "memory");
                                 xbar = xcd_barrier_post((unsigned*)a.ws, (volatile LAS unsigned*)(lds + LDS_XB)); }
            else xcd_barrier(xbar); }
    }
}

#ifndef MK_MULTI_X
#define MK_MULTI 0
#endif
extern "C" void kernel_launch(void* const* d_in, const int* in_sizes, int n_in, void* d_out, int out_size, void* d_ws, size_t ws_size, hipStream_t stream) {
    static int grid = 0;
    if (grid == 0) {
        int dev = 0, cus = 0, per_cu = 0;
        if (n_in != 22 || out_size != MTOK * DM || ws_size < WS_END) { fprintf(stderr, "kernel_launch: unexpected shapes (n_in %d out %d ws %zu need %zu)\n", n_in, out_size, ws_size, (size_t)WS_END); grid = -1; return; }
        (void)hipGetDevice(&dev);
        (void)hipDeviceGetAttribute(&cus, hipDeviceAttributeMultiprocessorCount, dev);
        (void)hipFuncSetAttribute((const void*)fwd_kernel, hipFuncAttributeMaxDynamicSharedMemorySize, LDS_BYTES);
        (void)hipOccupancyMaxActiveBlocksPerMultiprocessor(&per_cu, (const void*)fwd_kernel, NTHR, LDS_BYTES);
        if (per_cu < 1) per_cu = 1;
        grid = cus * per_cu;
        fprintf(stderr, "kernel_launch: grid %d (cus %d x %d), ws %zu\n", grid, cus, per_cu, ws_size);
    }
    if (grid < 0) return;
    Args a{};
    for (int i = 0; i < 22; ++i) a.in[i] = (const float*)d_in[i];
    a.out = (float*)d_out; a.ws = (unsigned char*)d_ws;
    constexpr int NPH = 1 + 7 * DEPTH;
#if MK_MULTI
    for (int ph = 0; ph < NPH; ++ph) { a.ph_lo = ph; a.ph_hi = ph + 1; hipLaunchKernelGGL(fwd_kernel, dim3(grid), dim3(NTHR), LDS_BYTES, stream, a); }
#else
    a.ph_lo = 0; a.ph_hi = NPH;
    void* args[] = {&a};
    hipError_t e = hipLaunchCooperativeKernel((const void*)fwd_kernel, dim3(grid), dim3(NTHR), args, LDS_BYTES, stream);
    if (e != hipSuccess) fprintf(stderr, "kernel_launch: cooperative launch failed: %s (grid %d)\n", hipGetErrorString(e), grid);
#endif
}
```
